# Optimizing an MI355X kernel written in HIP

```python
import jax, jax.numpy as jnp
from jax import lax
import numpy as np

D_MODEL = 1024
BATCH = 32
SEQ = 256
DEPTH = 4
DEC_BATCH = 4
DEC_SEQ = 1024
PAST_LEN = 256

GRID_W = 64
D_LRU = D_MODEL // 2
LRU_HEADS = 8
LRU_HEAD_DIM = D_LRU // LRU_HEADS
CONV_WIDTH = 4
CONV_PAD_LEFT = 2
LRU_C = 8.0
D_SGU = D_MODEL // 2
SGU_GROUPS = 4
SGU_GROUP_DIM = D_SGU // SGU_GROUPS
CHUNK = 2 * GRID_W
FNET_GROUPS = 4
FNET_GROUP_DIM = D_MODEL // FNET_GROUPS
D_FF = 4 * D_MODEL
N_AB_LAYERS = (DEPTH + 1) // 2
N_C_LAYERS = DEPTH // 2
N_MOD = 6
DEEPNORM_ALPHA = (2.0 * DEPTH) ** 0.25
DEEPNORM_BETA = (8.0 * DEPTH) ** -0.25
LN_EPS = 1e-5

kernel_name = "hybrid_lru_sgu_fnet_diffusion_step"


def layer_norm(x, g, b):
    xf = x.astype(jnp.float32)
    mu = jnp.mean(xf, axis=-1, keepdims=True)
    var = jnp.mean(jnp.square(xf - mu), axis=-1, keepdims=True)
    return ((xf - mu) * lax.rsqrt(var + LN_EPS) * g + b).astype(x.dtype)


def ada_mod(cond, w, b):
    m = jax.nn.silu(cond) @ w + b
    return jnp.split(m[:, None, :], N_MOD, axis=-1)


def centred_dwconv(x, w, b):
    S = x.shape[1]
    xp = jnp.pad(x, ((0, 0), (CONV_PAD_LEFT, CONV_WIDTH - 1 - CONV_PAD_LEFT), (0, 0)))
    return sum(xp[:, k:k + S] * w[k] for k in range(CONV_WIDTH)) + b


def _affine_combine(left, right):
    a_l, b_l = left
    a_r, b_r = right
    return a_l * a_r, a_r * b_l + b_r


def rg_lru(xc, wa, ba, wx, bx, lam, h0):
    B_, S = xc.shape[:2]
    xh = xc.reshape(B_, S, LRU_HEADS, LRU_HEAD_DIM)
    r = jax.nn.sigmoid(jnp.einsum('bshi,hij->bshj', xh, wa.astype(jnp.float32)).reshape(B_, S, D_LRU) + ba)
    i = jax.nn.sigmoid(jnp.einsum('bshi,hij->bshj', xh, wx.astype(jnp.float32)).reshape(B_, S, D_LRU) + bx)
    log_a = -LRU_C * r * jax.nn.softplus(-lam.astype(jnp.float32))
    a = jnp.exp(log_a)
    u = jnp.sqrt(-jnp.expm1(2.0 * log_a)) * (i * xc)
    u = u.at[:, 0].add(a[:, 0] * h0.astype(jnp.float32))
    _, h = lax.associative_scan(_affine_combine, (a, u), axis=1)
    return h


def lru_mixer(x_br, gate_br, j, h0_f, h0_b, conv_w, conv_b, lru_wa, lru_ba, lru_wx, lru_bx, lru_lam):
    xc = centred_dwconv(x_br, conv_w[j], conv_b[j]).astype(jnp.float32)
    h_f = rg_lru(xc, lru_wa[j, 0], lru_ba[j, 0], lru_wx[j, 0], lru_bx[j, 0], lru_lam[j, 0], h0_f)
    h_b = jnp.flip(rg_lru(jnp.flip(xc, 1), lru_wa[j, 1], lru_ba[j, 1], lru_wx[j, 1], lru_bx[j, 1],
                          lru_lam[j, 1], h0_b), 1)
    y = ((h_f + h_b) * jax.nn.gelu(gate_br.astype(jnp.float32))).astype(x_br.dtype)
    return y, h_f, h_b


def sgu_mixer(u, v, g, b, ws, bs):
    B_, S = u.shape[:2]
    u = jax.nn.gelu(u)
    v = layer_norm(jax.nn.gelu(v), g, b)
    vc = v.reshape(B_, S // CHUNK, CHUNK, SGU_GROUPS, SGU_GROUP_DIM)
    mix = jnp.einsum('gpq,bcqgd->bcpgd', ws, vc) + bs.T[None, None, :, :, None]
    return u * mix.reshape(B_, S, D_SGU)


def fourier_mixer(h):
    B_, S = h.shape[:2]
    hg = h.astype(jnp.float32).reshape(B_, S, FNET_GROUPS, FNET_GROUP_DIM)
    f = jnp.fft.fft2(hg, axes=(1, 3), norm='ortho').real
    return f.reshape(B_, S, D_MODEL).astype(h.dtype)


def run_trunk(x, cond, lru_h0, collect_state, w_ada, b_ada, w_in_ab, conv_w, conv_b, lru_wa, lru_ba,
              lru_wx, lru_bx, lru_lam, sgu_ln_g, sgu_ln_b, sgu_ws, sgu_bs, w_out_ab, w_out_c,
              ffn_w1, ffn_w2, ln_g, ln_b):
    finals = []
    for l in range(DEPTH):
        sh1, sc1, g1, sh2, sc2, g2 = ada_mod(cond, w_ada[l], b_ada[l])
        h = x * (1 + sc1) + sh1
        j = l // 2
        if l % 2 == 0:
            proj = h @ w_in_ab[j]
            xa, ga, ub, vb = jnp.split(proj, 4, axis=-1)
            ya, h_f, h_b = lru_mixer(xa, ga, j, lru_h0[:, j, 0], lru_h0[:, j, 1], conv_w, conv_b,
                                     lru_wa, lru_ba, lru_wx, lru_bx, lru_lam)
            yb = sgu_mixer(ub, vb, sgu_ln_g[j], sgu_ln_b[j], sgu_ws[j], sgu_bs[j])
            mix = jnp.concatenate([ya, yb], axis=-1) @ w_out_ab[j]
            if collect_state:
                finals.append(jnp.stack([h_f[:, -1], h_b[:, 0]], axis=1).astype(x.dtype))
        else:
            mix = fourier_mixer(h) @ w_out_c[j]
        x = layer_norm(DEEPNORM_ALPHA * x + g1 * mix, ln_g[l, 0], ln_b[l, 0])
        h = x * (1 + sc2) + sh2
        f = jnp.square(jax.nn.relu(h @ ffn_w1[l])) @ ffn_w2[l]
        x = layer_norm(DEEPNORM_ALPHA * x + g2 * f, ln_g[l, 1], ln_b[l, 1])
    state = jnp.stack(finals, axis=1) if collect_state else None
    return x, state


def setup_inputs(seed: int = 0) -> dict:
    key = jax.random.key(seed)
    ks = jax.random.split(key, 32)
    nrm = jax.random.normal
    D = D_MODEL
    a0 = jax.random.uniform(ks[14], (N_AB_LAYERS, 2, D_LRU), jnp.float32, minval=0.9, maxval=0.999)
    return {
        "x_prompt": nrm(ks[0], (BATCH, SEQ, D), jnp.float32),
        "x_sample": nrm(ks[1], (DEC_BATCH, DEC_SEQ, D), jnp.float32),
        "state_lru": 0.5 * nrm(ks[2], (DEC_BATCH, N_AB_LAYERS, 2, D_LRU), jnp.float32),
        "c": nrm(ks[3], (DEC_BATCH, D), jnp.float32),
        "c_ctx": nrm(ks[4], (D,), jnp.float32),
        "w_ada": nrm(ks[5], (DEPTH, D, N_MOD * D), jnp.float32) * D ** -0.5,
        "b_ada": 0.02 * nrm(ks[6], (DEPTH, N_MOD * D), jnp.float32),
        "w_in_ab": nrm(ks[7], (N_AB_LAYERS, D, 2 * D_LRU + 2 * D_SGU), jnp.float32) * D ** -0.5,
        "conv_w": nrm(ks[8], (N_AB_LAYERS, CONV_WIDTH, D_LRU), jnp.float32) * CONV_WIDTH ** -0.5,
        "conv_b": 0.02 * nrm(ks[9], (N_AB_LAYERS, D_LRU), jnp.float32),
        "lru_wa": nrm(ks[10], (N_AB_LAYERS, 2, LRU_HEADS, LRU_HEAD_DIM, LRU_HEAD_DIM), jnp.float32) * LRU_HEAD_DIM ** -0.5,
        "lru_ba": 0.02 * nrm(ks[11], (N_AB_LAYERS, 2, D_LRU), jnp.float32),
        "lru_wx": nrm(ks[12], (N_AB_LAYERS, 2, LRU_HEADS, LRU_HEAD_DIM, LRU_HEAD_DIM), jnp.float32) * LRU_HEAD_DIM ** -0.5,
        "lru_bx": 0.02 * nrm(ks[13], (N_AB_LAYERS, 2, D_LRU), jnp.float32),
        "lru_lam": jnp.log(a0) - jnp.log1p(-a0),
        "sgu_ln_g": 1.0 + 0.02 * nrm(ks[15], (N_AB_LAYERS, D_SGU), jnp.float32),
        "sgu_ln_b": 0.02 * nrm(ks[16], (N_AB_LAYERS, D_SGU), jnp.float32),
        "sgu_ws": nrm(ks[17], (N_AB_LAYERS, SGU_GROUPS, CHUNK, CHUNK), jnp.float32) * CHUNK ** -0.5,
        "sgu_bs": 1.0 + 0.02 * nrm(ks[18], (N_AB_LAYERS, SGU_GROUPS, CHUNK), jnp.float32),
        "w_out_ab": nrm(ks[19], (N_AB_LAYERS, D_LRU + D_SGU, D), jnp.float32) * (D_LRU + D_SGU) ** -0.5 * DEEPNORM_BETA,
        "w_out_c": nrm(ks[20], (N_C_LAYERS, D, D), jnp.float32) * D ** -0.5 * DEEPNORM_BETA,
        "ffn_w1": nrm(ks[21], (DEPTH, D, D_FF), jnp.float32) * D ** -0.5,
        "ffn_w2": nrm(ks[22], (DEPTH, D_FF, D), jnp.float32) * D_FF ** -0.5 * DEEPNORM_BETA,
        "ln_g": 1.0 + 0.02 * nrm(ks[23], (DEPTH, 2, D), jnp.float32),
        "ln_b": 0.02 * nrm(ks[24], (DEPTH, 2, D), jnp.float32),
    }


def reference(x_prompt, x_sample, state_lru, c, c_ctx, w_ada, b_ada, w_in_ab, conv_w, conv_b,
              lru_wa, lru_ba, lru_wx, lru_bx, lru_lam, sgu_ln_g, sgu_ln_b, sgu_ws, sgu_bs,
              w_out_ab, w_out_c, ffn_w1, ffn_w2, ln_g, ln_b):
    weights = (w_ada, b_ada, w_in_ab, conv_w, conv_b, lru_wa, lru_ba, lru_wx, lru_bx, lru_lam,
               sgu_ln_g, sgu_ln_b, sgu_ws, sgu_bs, w_out_ab, w_out_c, ffn_w1, ffn_w2, ln_g, ln_b)
    zero_h0 = jnp.zeros((x_prompt.shape[0], N_AB_LAYERS, 2, D_LRU), jnp.float32)
    y_prompt, new_state_lru = run_trunk(x_prompt, c_ctx[None, :], zero_h0, True, *weights)
    y_sample, _ = run_trunk(x_sample, c, state_lru, False, *weights)
    return (y_prompt, y_sample, new_state_lru)
```

```cpp
#include <hip/hip_runtime.h>
#include <hip/hip_cooperative_groups.h>
#include <cstdio>
namespace cg = cooperative_groups;

#ifndef PER_PHASE_LAUNCH
#define PER_PHASE_LAUNCH 0
#endif

#define LAS __attribute__((address_space(3)))
#define GAS __attribute__((address_space(1)))
typedef unsigned short bf16_t;
typedef short bf16x8 __attribute__((ext_vector_type(8)));
typedef float f32x4 __attribute__((ext_vector_type(4)));
typedef float f32x2 __attribute__((ext_vector_type(2)));
typedef unsigned u32x4 __attribute__((ext_vector_type(4)));
typedef unsigned u32x2 __attribute__((ext_vector_type(2)));

constexpr int T = 12288, TC = 8192, D = 1024, DFF = 4096;
constexpr int NTHR = 512;
constexpr int LDS_BYTES = 131072 + 16;
constexpr float ALPHA = 1.681792830507429f;
constexpr float LN_EPS = 1e-5f;

constexpr size_t OFF_WIN = 0;
constexpr size_t OFF_WOAB = OFF_WIN + 8388608;
constexpr size_t OFF_WOC = OFF_WOAB + 4194304;
constexpr size_t OFF_W1 = OFF_WOC + 4194304;
constexpr size_t OFF_W2 = OFF_W1 + 33554432;
constexpr size_t OFF_MOD = OFF_W2 + 33554432;
constexpr size_t OFF_CS256 = OFF_MOD + 491520;
constexpr size_t OFF_AS256 = OFF_CS256 + 262144;
constexpr size_t OFF_AS1024 = OFF_AS256 + 262144;
constexpr size_t OFF_AGG = OFF_AS1024 + 4194304;
constexpr size_t OFF_TAB = OFF_AGG + 131072;
constexpr size_t OFF_BAR = OFF_TAB + 256;
constexpr size_t OFF_CNT = OFF_BAR + 16384;
constexpr size_t OFF_LCNT = OFF_CNT + 131072;
constexpr size_t OFF_XCH = OFF_LCNT + 8192;
constexpr size_t OFF_PP = OFF_XCH + 393216;
constexpr int PP_CONVW = 0, PP_CONVB = 4096, PP_BA = 5120, PP_BX = 7168, PP_SP = 9216, PP_SGLG = 11264, PP_SGLB = 12288, PP_SGBS = 13312, PP_LNG = 14336, PP_LNB = 22528, PP_STATE = 30720, PP_END = 38912;
constexpr size_t OFF_PWT = OFF_PP + 155648;
constexpr size_t OFF_PSGW = OFF_PWT + 524288;
constexpr size_t OFF_XW = OFF_PSGW + 262144;
constexpr size_t OFF_H = OFF_XW + 50331648;
constexpr size_t OFF_PROJ = OFF_H + 25165824;
constexpr size_t OFF_YAB = OFF_PROJ + 50331648;
constexpr size_t OFF_F1 = OFF_YAB + 25165824;
constexpr size_t OFF_END = OFF_F1 + 100663296;

struct Params {
    const float* in[25];
    float* out;
    unsigned char* ws;
    int lo, hi;
};

__device__ __forceinline__ const float* tabp(const unsigned char* ws, int i) {
    const unsigned long long v = ((const unsigned long long*)(ws + OFF_TAB))[i];
    const unsigned lo = __builtin_amdgcn_readfirstlane((unsigned)v), hi = __builtin_amdgcn_readfirstlane((unsigned)(v >> 32));
    return (const float*)(((unsigned long long)hi << 32) | lo);
}
__device__ __forceinline__ int fresh_tid(int wv) { int l; asm volatile("v_mbcnt_lo_u32_b32 %0, -1, 0\n\tv_mbcnt_hi_u32_b32 %0, -1, %0" : "=v"(l)); return wv * 64 + l; }
__device__ __forceinline__ float bf2f(unsigned b) { return __uint_as_float(b << 16); }
__device__ __forceinline__ unsigned cvt_pk_bf16(float lo, float hi) { unsigned r; asm("v_cvt_pk_bf16_f32 %0, %1, %2" : "=v"(r) : "v"(lo), "v"(hi)); return r; }
__device__ __forceinline__ bf16_t f2bf(float x) { return (bf16_t)(cvt_pk_bf16(x, 0.f) & 0xffffu); }
__device__ __forceinline__ float fexp(float x) { return __builtin_amdgcn_exp2f(x * 1.4426950408889634f); }
__device__ __forceinline__ float flog(float x) { return __builtin_amdgcn_logf(x) * 0.6931471805599453f; }
__device__ __forceinline__ float sigmoidf_(float x) { return __builtin_amdgcn_rcpf(1.0f + fexp(-x)); }
__device__ __forceinline__ float lane_xor(float v, int lane, int o) { return __int_as_float(__builtin_amdgcn_ds_bpermute((lane ^ o) << 2, __float_as_int(v))); }
__device__ __forceinline__ float gelu_tanh(float x) { const float z = 1.5957691216057308f * (x + 0.044715f * x * x * x); return x * __builtin_amdgcn_rcpf(1.0f + fexp(-z)); }
__device__ __forceinline__ float wave_sum(float v, int lane) {
#pragma unroll
    for (int o = 32; o >= 1; o >>= 1) v += lane_xor(v, lane, o);
    return v;
}

namespace pg8 {
constexpr int BM = 256, BK = 64, HALF = 128, HTB = HALF * BK * 2, NXCD = 8, WGM = 8;
__device__ __forceinline__ int lds_byte(int r, int c) { const int st = (r >> 4) * 2 + (c >> 5), rr = r & 15, cc = c & 31, ob = rr * 64 + cc * 2; return st * 1024 + (ob ^ (((ob >> 9) & 1) << 5)); }
__device__ __forceinline__ void stage_rc(int b, int& R, int& C) { const int st = b / 1024, sb = b % 1024, swz = sb ^ (((sb >> 9) & 1) << 5); R = (st >> 1) * 16 + swz / 64; C = (st & 1) * 32 + (swz % 64) / 2; }
__device__ __forceinline__ int perm32(int rho) { const int n = rho >> 4, i = rho & 15; return 8 * (i >> 2) + 4 * n + (i & 3); }

struct Unit { const char* a; const char* b; bf16_t* o; float* x; const float* gate; int ldc; int flag; int pm, pn, cond; };

template <int ACT  > struct EpiBf {
    static constexpr bool PERM = true, AFTER_DRAIN = false;
    template <int MT> __device__ __forceinline__ void operator()(const f32x4 (&acc)[2][2][MT][2], const Unit& u, const int wv) const {
        const int lane = fresh_tid(wv) & 63, wr = wv >> 2, wc = wv & 3, fr = lane & 15, fq = lane >> 4;
        const int r0 = wr * (16 * MT) + fr;
        const __amdgpu_buffer_rsrc_t rs = __builtin_amdgcn_make_buffer_rsrc((void*)u.o, 0, 0x7fffffff, 0x00020000);
        const unsigned base = ((unsigned)r0 * (unsigned)u.ldc + (unsigned)(wc * 32 + 8 * fq)) * 2u;
#pragma unroll
        for (int ai = 0; ai < 2; ++ai)
#pragma unroll
            for (int m = 0; m < MT; ++m) {
                const unsigned rowp = base + (unsigned)(ai * (32 * MT) + m * 16) * (unsigned)u.ldc * 2u;
#pragma unroll
                for (int bj = 0; bj < 2; ++bj) {
                    f32x4 v0 = acc[ai][bj][m][0], v1 = acc[ai][bj][m][1];
                    if (ACT == 1) { if (u.flag) {
#pragma unroll
                        for (int j = 0; j < 4; ++j) { v0[j] = gelu_tanh(v0[j]); v1[j] = gelu_tanh(v1[j]); } } }
                    if (ACT == 2) {
#pragma unroll
                        for (int j = 0; j < 4; ++j) { const float a = fmaxf(v0[j], 0.f), b = fmaxf(v1[j], 0.f); v0[j] = a * a; v1[j] = b * b; } }
                    u32x4 w; w.x = cvt_pk_bf16(v0[0], v0[1]); w.y = cvt_pk_bf16(v0[2], v0[3]); w.z = cvt_pk_bf16(v1[0], v1[1]); w.w = cvt_pk_bf16(v1[2], v1[3]);
                    __builtin_amdgcn_raw_buffer_store_b128(w, rs, rowp + bj * HALF * 2, 0, 18);
                }
            }
    }
};
__device__ __forceinline__ int cond_of_row(int rg) { return rg < TC ? 0 : 1 + ((rg - TC) >> 10); }
struct EpiResidLn {
    static constexpr bool PERM = true, AFTER_DRAIN = true;
    const float* lng; const float* lnb; const float* gatebase; const float* modn; bf16_t* xw; float* outf; bf16_t* hb;
    unsigned long long* xbuf; unsigned* cnt;
    template <int MT> __device__ __forceinline__ void fused(f32x4 (&acc)[2][2][MT][2], const Unit& u, const int wv, LAS unsigned char* lds) const {
        constexpr int RT = 64 * MT, RH = 32 * MT, RW = 16 * MT;
        const int lane = fresh_tid(wv) & 63, wid = wv, wr = wv >> 2, wc = wv & 3, fr = lane & 15, fq = lane >> 4;
        const int colg0 = u.pn * BM + wc * 32 + 8 * fq;
        const int rg0 = u.pm * RT + wr * RW + fr;
        const int cond0 = cond_of_row(u.pm * RT); const bool uni = cond0 == cond_of_row(u.pm * RT + RT - 1);
#pragma unroll
        for (int bj = 0; bj < 2; ++bj) {
            const int cg = colg0 + bj * HALF;
            f32x4 g0 = *(const f32x4*)(gatebase + cond0 * 6144 + cg), g1 = *(const f32x4*)(gatebase + cond0 * 6144 + cg + 4);
            u32x4 xr[2][MT];
#pragma unroll
            for (int ai = 0; ai < 2; ++ai)
#pragma unroll
                for (int m = 0; m < MT; ++m) xr[ai][m] = *(const GAS u32x4*)((const GAS bf16_t*)xw + ((unsigned)(rg0 + ai * RH + m * 16) * 1024u + (unsigned)cg));
#pragma unroll
            for (int ai = 0; ai < 2; ++ai)
#pragma unroll
                for (int m = 0; m < MT; ++m) {
                    if (!uni) { const float* gp = gatebase + cond_of_row(rg0 + ai * RH + m * 16) * 6144 + cg; g0 = *(const f32x4*)gp; g1 = *(const f32x4*)(gp + 4); }
                    const u32x4 r = xr[ai][m];
                    const f32x4 x0 = (f32x4){bf2f(r.x & 0xffffu), bf2f(r.x >> 16), bf2f(r.y & 0xffffu), bf2f(r.y >> 16)}, x1 = (f32x4){bf2f(r.z & 0xffffu), bf2f(r.z >> 16), bf2f(r.w & 0xffffu), bf2f(r.w >> 16)};
                    acc[ai][bj][m][0] = x0 * ALPHA + g0 * acc[ai][bj][m][0]; acc[ai][bj][m][1] = x1 * ALPHA + g1 * acc[ai][bj][m][1];
                }
            asm volatile("" ::: "memory");
        }
        LAS f32x2* P = (LAS f32x2*)lds;
        LAS f32x2* S = (LAS f32x2*)(lds + 8192);
#pragma unroll
        for (int ai = 0; ai < 2; ++ai)
#pragma unroll
            for (int m = 0; m < MT; ++m) {
                float s = 0.f;
#pragma unroll
                for (int bj = 0; bj < 2; ++bj)
#pragma unroll
                    for (int n = 0; n < 2; ++n) { const f32x4 x = acc[ai][bj][m][n]; s += (x[0] + x[1]) + (x[2] + x[3]); }
                s += lane_xor(s, lane, 16); s += lane_xor(s, lane, 32);
                const float mw = s * (1.0f / 64.0f); float q = 0.f;
#pragma unroll
                for (int bj = 0; bj < 2; ++bj)
#pragma unroll
                    for (int n = 0; n < 2; ++n) { const f32x4 d = acc[ai][bj][m][n] - mw; q += (d[0] * d[0] + d[1] * d[1]) + (d[2] * d[2] + d[3] * d[3]); }
                q += lane_xor(q, lane, 16); q += lane_xor(q, lane, 32);
                if (fq == 0) P[(ai * RH + wr * RW + m * 16 + fr) * 4 + wc] = (f32x2){mw, q};
            }
        asm volatile("s_waitcnt lgkmcnt(0)" ::: "memory"); __builtin_amdgcn_s_barrier(); asm volatile("" ::: "memory");
        const int row = wid * 32 + (lane & 31);
        const bool pub = wid * 32 < RT;
        if (pub && lane < 32) {
            const f32x2 a = P[row * 4 + 0], b = P[row * 4 + 1], c = P[row * 4 + 2], d = P[row * 4 + 3];
            const float mt = (a.x + b.x + c.x + d.x) * 0.25f;
            const float da = a.x - mt, db = b.x - mt, dc = c.x - mt, dd = d.x - mt;
            const float m2 = (a.y + b.y) + (c.y + d.y) + 64.0f * ((da * da + db * db) + (dc * dc + dd * dd));
            unsigned long long* slot = xbuf + ((size_t)(u.pm * RT + row) * 4 + u.pn);
            __hip_atomic_store(slot, ((unsigned long long)__float_as_uint(m2) << 32) | __float_as_uint(mt), __ATOMIC_RELAXED, __HIP_MEMORY_SCOPE_AGENT);
        }
        asm volatile("s_waitcnt vmcnt(0)" ::: "memory");
        if (pub && lane == 0) __hip_atomic_fetch_add(cnt + 64 * u.pm, 1u, __ATOMIC_RELAXED, __HIP_MEMORY_SCOPE_AGENT);
        if (wid == 0) {
            unsigned sp = 0;
            while ((unsigned)__builtin_amdgcn_readfirstlane(__hip_atomic_load(cnt + 64 * u.pm, __ATOMIC_RELAXED, __HIP_MEMORY_SCOPE_AGENT)) < (unsigned)(RT / 32 * 4)) { __builtin_amdgcn_s_sleep(1); if (++sp > (1u << 22)) break; }
            __builtin_amdgcn_fence(__ATOMIC_ACQUIRE, "agent");
        }
        asm volatile("s_waitcnt vmcnt(0) lgkmcnt(0)" ::: "memory"); __builtin_amdgcn_s_barrier(); asm volatile("" ::: "memory");
        if (pub && lane < 32) {
            const unsigned long long* slot = xbuf + (size_t)(u.pm * RT + row) * 4; float mt[4], m2[4]; float ms = 0.f;
#pragma unroll
            for (int t = 0; t < 4; ++t) { const unsigned long long w = __hip_atomic_load(slot + t, __ATOMIC_RELAXED, __HIP_MEMORY_SCOPE_AGENT); mt[t] = __uint_as_float((unsigned)w); m2[t] = __uint_as_float((unsigned)(w >> 32)); ms += mt[t]; }
            const float mean = ms * 0.25f; float q = 0.f;
#pragma unroll
            for (int t = 0; t < 4; ++t) { const float dm = mt[t] - mean; q += m2[t] + 256.0f * dm * dm; }
            S[row] = (f32x2){mean, __builtin_amdgcn_rsqf(q * (1.0f / 1024.0f) + LN_EPS)};
        }
        asm volatile("s_waitcnt lgkmcnt(0)" ::: "memory"); __builtin_amdgcn_s_barrier(); asm volatile("" ::: "memory");
        int rgs = rg0; asm volatile("" : "+v"(rgs));
#pragma unroll
        for (int bj = 0; bj < 2; ++bj) {
            const int cg = colg0 + bj * HALF;
            const f32x4 ga = *(const f32x4*)(lng + cg), gb = *(const f32x4*)(lng + cg + 4), ba = *(const f32x4*)(lnb + cg), bb = *(const f32x4*)(lnb + cg + 4);
            f32x4 sha = (f32x4){0.f, 0.f, 0.f, 0.f}, shb = sha, sca = sha, scb = sha;
            if (modn) { const float* mr = modn + cond0 * 6144 + cg; sha = *(const f32x4*)mr; shb = *(const f32x4*)(mr + 4); sca = *(const f32x4*)(mr + 1024) + 1.0f; scb = *(const f32x4*)(mr + 1028) + 1.0f; }
#pragma unroll
            for (int ai = 0; ai < 2; ++ai)
#pragma unroll
                for (int m = 0; m < MT; ++m) { const int rl = ai * RH + m * 16; const f32x2 sr = S[rl + wr * RW + fr];
                    const f32x4 y0 = (acc[ai][bj][m][0] - sr.x) * sr.y * ga + ba, y1 = (acc[ai][bj][m][1] - sr.x) * sr.y * gb + bb;
                    const unsigned off = (unsigned)(rgs + rl) * 1024u + (unsigned)cg;
                    if (!modn) { *(GAS f32x4*)((GAS float*)outf + off) = y0; *(GAS f32x4*)((GAS float*)outf + off + 4) = y1; }
                    else {
                        if (!uni) { const float* mr = modn + cond_of_row(rgs + rl) * 6144 + cg; sha = *(const f32x4*)mr; shb = *(const f32x4*)(mr + 4); sca = *(const f32x4*)(mr + 1024) + 1.0f; scb = *(const f32x4*)(mr + 1028) + 1.0f; }
                        u32x4 xo; xo.x = cvt_pk_bf16(y0[0], y0[1]); xo.y = cvt_pk_bf16(y0[2], y0[3]); xo.z = cvt_pk_bf16(y1[0], y1[1]); xo.w = cvt_pk_bf16(y1[2], y1[3]);
                        *(GAS u32x4*)((GAS bf16_t*)xw + off) = xo;
                        const f32x4 h0 = y0 * sca + sha, h1 = y1 * scb + shb;
                        u32x4 ho; ho.x = cvt_pk_bf16(h0[0], h0[1]); ho.y = cvt_pk_bf16(h0[2], h0[3]); ho.z = cvt_pk_bf16(h1[0], h1[1]); ho.w = cvt_pk_bf16(h1[2], h1[3]);
                        *(GAS u32x4*)((GAS bf16_t*)hb + off) = ho; } }
            asm volatile("" ::: "memory");
        }
    }
};

template <int MT, bool ALIGN_EPI, class Epi, class Sched>
__device__ __forceinline__ void gemm_phase(const int wv, LAS unsigned char* lds, const int lda, const int ldb, const int K, const Sched& S, const Epi& E, const int kjt = 1 << 30, const size_t kjb = 0) {
    const int tid = fresh_tid(wv);
    const int wid = __builtin_amdgcn_readfirstlane(tid >> 6), lane = tid & 63, wr = wid >> 2, wc = wid & 3, fr = lane & 15, fq = lane >> 4;
    const int nt = K / BK;
    unsigned voffA[2], voffB[2];
#pragma unroll
    for (int i = 0; i < 2; ++i) { int R, C; stage_rc(tid * 16 + i * 8192, R, C); const int Rb = Epi::PERM ? ((R & ~31) + perm32(R & 31)) : R;
        const int Ra = (MT == 3 && R >= 96) ? R - 32 : R;
        voffA[i] = (unsigned)(Ra * lda + C) * 2u; voffB[i] = (unsigned)(Rb * ldb + C) * 2u; }
    const size_t kstep = (size_t)(BK * 2);
    const size_t hstepA = (size_t)(32 * MT) * lda * 2, hstepB = (size_t)HALF * ldb * 2;
    const unsigned ldsw = (unsigned)wid * 1024u;
    const int aoff = lds_byte(wr * (16 * MT) + fr, fq * 8), boff = lds_byte(wc * 32 + fr, fq * 8);
    const bool light = (MT == 3) && (wr == 1);
#define PG8_SA(b, h) (((b) * 2 + (h)) * HTB)
#define PG8_SB(b, h) ((4 + (b) * 2 + (h)) * HTB)
#define PG8_STAGE(bufoff, gbase, voff) do { _Pragma("unroll") for (int _i = 0; _i < 2; ++_i) \
        __builtin_amdgcn_global_load_lds((const unsigned*)((const char*)(gbase) + (voff)[_i]), (LAS unsigned*)(lds + (bufoff) + ldsw + _i * 8192), 16, 0, 0); } while (0)
#define PG8_STAGEA(bufoff, gbase) do { __builtin_amdgcn_global_load_lds((const unsigned*)((const char*)(gbase) + voffA[0]), (LAS unsigned*)(lds + (bufoff) + ldsw), 16, 0, 0); \
        if (!light) __builtin_amdgcn_global_load_lds((const unsigned*)((const char*)(gbase) + voffA[1]), (LAS unsigned*)(lds + (bufoff) + ldsw + 8192), 16, 0, 0); } while (0)
#define PG8_WAIT_VL(nfull, nlight) do { if (light) PG8_WAIT_V(nlight); else PG8_WAIT_V(nfull); } while (0)
#define PG8_LDA(dst, b, h) do { _Pragma("unroll") for (int m = 0; m < MT; ++m) _Pragma("unroll") for (int k = 0; k < 2; ++k) dst[m][k] = *(const LAS bf16x8*)(lds + PG8_SA(b, h) + aoff + m * 2048 + k * 1024); } while (0)
#define PG8_LDB(dst, b, h) do { _Pragma("unroll") for (int n = 0; n < 2; ++n) _Pragma("unroll") for (int k = 0; k < 2; ++k) dst[n][k] = *(const LAS bf16x8*)(lds + PG8_SB(b, h) + boff + n * 2048 + k * 1024); } while (0)
#define PG8_MMA(ai, bj, At, Bt) do { __builtin_amdgcn_s_setprio(1); _Pragma("unroll") for (int m = 0; m < MT; ++m) _Pragma("unroll") for (int n = 0; n < 2; ++n) _Pragma("unroll") for (int k = 0; k < 2; ++k) \
        acc[ai][bj][m][n] = __builtin_amdgcn_mfma_f32_16x16x32_bf16(Bt[n][k], At[m][k], acc[ai][bj][m][n], 0, 0, 0); __builtin_amdgcn_s_setprio(0); } while (0)
#define PG8_WAIT_V(n) asm volatile("s_waitcnt vmcnt(" #n ")" ::: "memory")
#define PG8_WAIT_L(n) asm volatile("s_waitcnt lgkmcnt(" #n ")" ::: "memory")
#define PG8_WAIT_LA do { if constexpr (MT == 4) PG8_WAIT_L(8); else PG8_WAIT_L(6); } while (0)
#define PG8_BAR __builtin_amdgcn_s_barrier()
#define PG8_SCHED __builtin_amdgcn_sched_barrier(0)
    int ui = 0;
    const char* cA; const char* cB;
    { Unit u0; if (!S.next(0, u0)) return; cA = u0.a; cB = u0.b; }
    f32x4 acc[2][2][MT][2];
#pragma unroll
    for (int a = 0; a < 2; ++a)
#pragma unroll
        for (int b = 0; b < 2; ++b)
#pragma unroll
            for (int m = 0; m < MT; ++m)
#pragma unroll
                for (int n = 0; n < 2; ++n) acc[a][b][m][n] = (f32x4){0.f, 0.f, 0.f, 0.f};
    bf16x8 At[MT][2], B0[2][2], B1[2][2];
    PG8_STAGE(PG8_SB(0, 0), cB, voffB); PG8_STAGE(PG8_SB(0, 1), cB + hstepB, voffB); PG8_STAGEA(PG8_SA(0, 0), cA); PG8_STAGEA(PG8_SA(0, 1), cA + hstepA);
    if (wr == 1) PG8_BAR;
    PG8_WAIT_VL(2, 1); PG8_BAR;
    PG8_STAGE(PG8_SB(1, 0), cB + kstep, voffB); PG8_STAGEA(PG8_SA(1, 0), cA + kstep); PG8_STAGE(PG8_SB(1, 1), cB + hstepB + kstep, voffB);
    PG8_WAIT_VL(6, 5); PG8_BAR;
    for (;;) {
        const char* nA = cA; const char* nB = cB; bool has_next;
        { Unit un; has_next = S.next(ui + 1, un); if (has_next) { nA = un.a; nB = un.b; } }
        for (int t = 0; t < nt; t += 2) {
            const bool last = (t == nt - 2);
            const char* a1 = cA + (size_t)(t + 1) * kstep;
            const char* a2 = last ? nA : cA + (size_t)(t + 2) * kstep; const char* b2 = last ? nB : cB + (size_t)(t + 2) * kstep + (t + 2 >= kjt ? kjb : (size_t)0);
            const char* a3 = a2 + kstep; const char* b3 = b2 + kstep;
            PG8_LDB(B0, 0, 0); PG8_LDB(B1, 0, 1); PG8_SCHED; PG8_LDA(At, 0, 0); PG8_STAGEA(PG8_SA(1, 1), a1 + hstepA);
            PG8_WAIT_VL(8, 6); PG8_WAIT_L(0); PG8_BAR; PG8_MMA(0, 0, At, B0); PG8_MMA(0, 1, At, B1); PG8_BAR; PG8_SCHED;
            PG8_LDA(At, 0, 1); PG8_STAGE(PG8_SB(0, 0), b2, voffB); PG8_STAGE(PG8_SB(0, 1), b2 + hstepB, voffB); PG8_STAGEA(PG8_SA(0, 0), a2);
            PG8_WAIT_VL(8, 6); PG8_WAIT_L(0); PG8_BAR; PG8_MMA(1, 0, At, B0); PG8_MMA(1, 1, At, B1); PG8_BAR; PG8_SCHED;
            PG8_LDB(B0, 1, 0); PG8_LDB(B1, 1, 1); PG8_SCHED; PG8_LDA(At, 1, 0); PG8_STAGEA(PG8_SA(0, 1), a2 + hstepA);
            PG8_WAIT_VL(8, 6); PG8_WAIT_L(0); PG8_BAR; PG8_MMA(0, 0, At, B0); PG8_MMA(0, 1, At, B1); PG8_BAR; PG8_SCHED;
            PG8_LDA(At, 1, 1); PG8_STAGE(PG8_SB(1, 0), b3, voffB); PG8_STAGE(PG8_SB(1, 1), b3 + hstepB, voffB); PG8_STAGEA(PG8_SA(1, 0), a3);
            PG8_WAIT_VL(8, 6); PG8_WAIT_L(0); PG8_BAR; PG8_MMA(1, 0, At, B0); PG8_MMA(1, 1, At, B1); PG8_BAR; PG8_SCHED;
        }
        if constexpr (ALIGN_EPI) { if (wr == 0) PG8_BAR; }
        if constexpr (!Epi::AFTER_DRAIN) { Unit uc; (void)S.next(ui, uc); E.template operator()<MT>(acc, uc, wv); }
        if (!has_next) break;
#pragma unroll
        for (int a = 0; a < 2; ++a)
#pragma unroll
            for (int b = 0; b < 2; ++b)
#pragma unroll
                for (int m = 0; m < MT; ++m)
#pragma unroll
                    for (int n = 0; n < 2; ++n) acc[a][b][m][n] = (f32x4){0.f, 0.f, 0.f, 0.f};
        cA = nA; cB = nB; ++ui;
        if constexpr (ALIGN_EPI) { if (wr == 1) PG8_BAR; }
    }
    PG8_WAIT_V(0);
    if constexpr (!ALIGN_EPI) { if (wr == 0) PG8_BAR; }
    PG8_BAR;
    if constexpr (Epi::AFTER_DRAIN) { Unit uc; (void)S.next(ui, uc); E.template fused<MT>(acc, uc, wv, lds); }
#undef PG8_SA
#undef PG8_SB
#undef PG8_STAGE
#undef PG8_LDA
#undef PG8_STAGEA
#undef PG8_WAIT_VL
#undef PG8_LDB
#undef PG8_MMA
#undef PG8_WAIT_V
#undef PG8_WAIT_L
#undef PG8_WAIT_LA
#undef PG8_BAR
#undef PG8_SCHED
}

struct SchedDense {
    const bf16_t* A; const bf16_t* Bt; int lda, ldb, nM, nN, G, c, rt;
    bf16_t* O; int ldo;
    __device__ __forceinline__ bool next(int i, Unit& u) const {
        const unsigned nwg = (unsigned)(nM * nN); const unsigned L = (unsigned)i * (unsigned)G + (unsigned)c; if (L >= nwg) return false;
        const unsigned lnN = 31u - (unsigned)__builtin_clz((unsigned)nN);
        const unsigned wgid = (L & 7u) * (nwg >> 3) + (L >> 3);
        const unsigned w = wgid & ((8u << lnN) - 1u);
        const int pm = (int)(((wgid >> (3u + lnN)) << 3) + (w & 7u)), pn = (int)(w >> 3);
        u.a = (const char*)(A + (size_t)pm * rt * lda); u.b = (const char*)(Bt + (size_t)pn * 256 * ldb);
        u.o = O + (size_t)pm * rt * ldo + pn * 256; u.ldc = ldo; u.flag = pn >= 2;
        u.x = nullptr; u.gate = nullptr; u.pm = pm; u.pn = pn; u.cond = 0;
        return true;
    }
};
struct SchedD1 {
    const bf16_t* CS; const bf16_t* CSEO; const bf16_t* H; bf16_t* PQT; int G, c, part;
    __device__ __forceinline__ bool next(int i, Unit& u) const {
        if (c < 0) return false;
        const int idx = i * G + c;
        if (part == 0) { if (idx >= 128) return false; const int sb = idx >> 5, rem = idx & 31, g = rem >> 3, eo = (rem >> 2) & 1, pm = (rem >> 1) & 1, pn = rem & 1;
            u.a = (const char*)(CSEO + eo * 262144 + pm * 131072); u.b = (const char*)(H + (size_t)(TC + sb * 1024 + pn * 256) * 1024 + g * 256);
            u.o = PQT + 16777216 + (size_t)(sb * 4 + g) * 524288 + (eo * 2 + pm) * 512 + pn * 256; u.ldc = 2048; }
        else { if (idx >= 256) return false; const int seq = idx >> 3, rem = idx & 7, g = rem >> 1, pm = rem & 1;
            u.a = (const char*)(CS + pm * 65536); u.b = (const char*)(H + (size_t)(seq * 256) * 1024 + g * 256);
            u.o = PQT + (size_t)(seq * 4 + g) * 131072 + pm * 256; u.ldc = 512; }
        u.flag = 0; u.x = nullptr; u.gate = nullptr; u.pm = 0; u.pn = 0; u.cond = 0;
        return true;
    }
};
struct SchedD2 {
    const bf16_t* AS; const bf16_t* PQT; bf16_t* FM; int G, c, part;
    __device__ __forceinline__ bool next(int i, Unit& u) const {
        const int idx = i * G + c;
        if (part == 0) { if (idx >= 64) return false; const int sb = idx >> 4, g = (idx >> 2) & 3, eo = (idx >> 1) & 1, pm = idx & 1;
            u.a = (const char*)(AS + (size_t)eo * 524288 + (size_t)pm * 262144); u.b = (const char*)(PQT + 16777216 + (size_t)(sb * 4 + g) * 524288 + eo * 1024);
            u.o = FM + (size_t)(TC + sb * 1024 + pm * 512 + eo) * 1024 + g * 256; u.ldc = 2048; }
        else { if (idx >= 128) return false; const int seq = idx >> 2, g = idx & 3;
            u.a = (const char*)AS; u.b = (const char*)(PQT + (size_t)(seq * 4 + g) * 131072);
            u.o = FM + (size_t)(seq * 256) * 1024 + g * 256; u.ldc = 1024; }
        u.flag = 0; u.x = nullptr; u.gate = nullptr; u.pm = 0; u.pn = 0; u.cond = 0;
        return true;
    }
};
}

struct TrTile { const float* src; bf16_t* dst; int N, Kd, k0, n0; };
__device__ __forceinline__ TrTile tr_decode(const Params& p, unsigned char* ws, int id) {
    TrTile r;
    if (id < 1024) { const int b = id >> 9, q = id & 511; r.N = 2048; r.Kd = 1024; r.k0 = (q >> 5) * 64; r.n0 = (q & 31) * 64; r.src = p.in[7] + (size_t)b * 1024 * 2048; r.dst = (bf16_t*)(ws + OFF_WIN) + (size_t)b * 2048 * 1024; }
    else if (id < 1536) { const int q0 = id - 1024, b = q0 >> 8, q = q0 & 255; r.N = 1024; r.Kd = 1024; r.k0 = (q >> 4) * 64; r.n0 = (q & 15) * 64; r.src = p.in[19] + (size_t)b * 1048576; r.dst = (bf16_t*)(ws + OFF_WOAB) + (size_t)b * 1048576; }
    else if (id < 2048) { const int q0 = id - 1536, b = q0 >> 8, q = q0 & 255; r.N = 1024; r.Kd = 1024; r.k0 = (q >> 4) * 64; r.n0 = (q & 15) * 64; r.src = p.in[20] + (size_t)b * 1048576; r.dst = (bf16_t*)(ws + OFF_WOC) + (size_t)b * 1048576; }
    else if (id < 6144) { const int q0 = id - 2048, b = q0 >> 10, q = q0 & 1023; r.N = 4096; r.Kd = 1024; r.k0 = (q >> 6) * 64; r.n0 = (q & 63) * 64; r.src = p.in[21] + (size_t)b * 4194304; r.dst = (bf16_t*)(ws + OFF_W1) + (size_t)b * 4194304; }
    else { const int q0 = id - 6144, b = q0 >> 10, q = q0 & 1023; r.N = 1024; r.Kd = 4096; r.k0 = (q >> 4) * 64; r.n0 = (q & 15) * 64; r.src = p.in[22] + (size_t)b * 4194304; r.dst = (bf16_t*)(ws + OFF_W2) + (size_t)b * 4194304; }
    return r;
}
__device__ __forceinline__ void transpose_batch(const Params& p, unsigned char* ws, int id0, float* tl) {
    const int t = threadIdx.x;
    f32x4 v[4][2];
#pragma unroll
    for (int b = 0; b < 4; ++b) { const TrTile tt = tr_decode(p, ws, id0 + b);
#pragma unroll
        for (int i = 0; i < 2; ++i) { const int idx = t + i * 512, r = idx >> 4, c4 = (idx & 15) * 4; v[b][i] = __builtin_nontemporal_load((const f32x4*)(tt.src + (size_t)(tt.k0 + r) * tt.N + tt.n0 + c4)); } }
#pragma unroll
    for (int b = 0; b < 4; ++b)
#pragma unroll
        for (int i = 0; i < 2; ++i) { const int idx = t + i * 512, r = idx >> 4, c4 = (idx & 15) * 4; float* d = tl + b * 4160 + r * 65 + c4; d[0] = v[b][i][0]; d[1] = v[b][i][1]; d[2] = v[b][i][2]; d[3] = v[b][i][3]; }
    __syncthreads();
    const int n = t >> 3, k8 = (t & 7) * 8;
#pragma unroll
    for (int b = 0; b < 4; ++b) { const TrTile tt = tr_decode(p, ws, id0 + b);
        float e[8];
#pragma unroll
        for (int i = 0; i < 8; ++i) e[i] = tl[b * 4160 + (k8 + i) * 65 + n];
        u32x4 w; w.x = cvt_pk_bf16(e[0], e[1]); w.y = cvt_pk_bf16(e[2], e[3]); w.z = cvt_pk_bf16(e[4], e[5]); w.w = cvt_pk_bf16(e[6], e[7]);
        *(u32x4*)(tt.dst + (size_t)(tt.n0 + n) * tt.Kd + tt.k0 + k8) = w; }
    __syncthreads();
}

__device__ __forceinline__ void phase0(const Params& p, float* lds) {
    const int t = threadIdx.x;
    unsigned char* ws = p.ws;
    if (t < 25) ((const float**)(ws + OFF_TAB))[t] = p.in[t];
    for (int u = blockIdx.x; u < 192; u += gridDim.x) {
        float* S = lds;
        float* red = lds + 5120;
        for (int i = t; i < 5120; i += NTHR) { const int ci = i >> 10, k = i & 1023; const float cv = ci == 0 ? p.in[4][k] : p.in[3][(ci - 1) * 1024 + k]; S[i] = cv * sigmoidf_(cv); }
        __syncthreads();
        const int col0 = u * 128, l = col0 / 6144, n0 = col0 % 6144, cq = t & 31, ks = t >> 5;
        float acc[5][4];
#pragma unroll
        for (int ci = 0; ci < 5; ++ci)
#pragma unroll
            for (int e = 0; e < 4; ++e) acc[ci][e] = 0.f;
        const float* wp = p.in[5] + ((size_t)l * 1024 + ks * 64) * 6144 + n0 + cq * 4;
#pragma unroll 4
        for (int kk = 0; kk < 64; ++kk) {
            const f32x4 w = *(const f32x4*)(wp + (size_t)kk * 6144);
#pragma unroll
            for (int ci = 0; ci < 5; ++ci) { const float s = S[ci * 1024 + ks * 64 + kk];
#pragma unroll
                for (int e = 0; e < 4; ++e) acc[ci][e] += s * w[e]; }
        }
#pragma unroll
        for (int ci = 0; ci < 5; ++ci)
#pragma unroll
            for (int e = 0; e < 4; ++e) red[(ks * 5 + ci) * 128 + cq * 4 + e] = acc[ci][e];
        __syncthreads();
        float* mod = (float*)(ws + OFF_MOD);
        for (int o = t; o < 640; o += NTHR) { const int ci = o >> 7, cn = o & 127; float s = 0.f;
#pragma unroll
            for (int k2 = 0; k2 < 16; ++k2) s += red[(k2 * 5 + ci) * 128 + cn];
            mod[(l * 5 + ci) * 6144 + n0 + cn] = s + p.in[6][l * 6144 + n0 + cn]; }
        __syncthreads();
    }
    for (int id0 = blockIdx.x * 4; id0 < 10240; id0 += gridDim.x * 4) transpose_batch(p, ws, id0, lds);
    {
        const int gtid = blockIdx.x * NTHR + t, gsz = gridDim.x * NTHR;
        float* pp = (float*)(ws + OFF_PP);
        for (int i = gtid; i < PP_END; i += gsz) { float v;
            if (i < PP_CONVB) v = p.in[8][i]; else if (i < PP_BA) v = p.in[9][i - PP_CONVB]; else if (i < PP_BX) v = p.in[11][i - PP_BA]; else if (i < PP_SP) v = p.in[13][i - PP_BX];
            else if (i < PP_SGLG) { const float lam = p.in[14][i - PP_SP]; v = flog(1.0f + fexp(-lam)); }
            else if (i < PP_SGLB) v = p.in[15][i - PP_SGLG]; else if (i < PP_SGBS) v = p.in[16][i - PP_SGLB]; else if (i < PP_LNG) v = p.in[18][i - PP_SGBS];
            else if (i < PP_LNB) v = p.in[23][i - PP_LNG]; else if (i < PP_STATE) v = p.in[24][i - PP_LNB]; else v = p.in[2][i - PP_STATE];
            pp[i] = v; }
        bf16_t* pwt = (bf16_t*)(ws + OFF_PWT);
        for (int i = gtid; i < 262144; i += gsz) { const int ii = i & 63, oo = (i >> 6) & 63, m = (i >> 12) & 3, hd = (i >> 14) & 7, j = i >> 17;
            const float* s = ((m & 1) ? p.in[12] : p.in[10]) + (size_t)(((j * 2 + (m >> 1)) * 8 + hd) * 4096);
            pwt[i] = f2bf(s[ii * 64 + oo]); }
        bf16_t* psg = (bf16_t*)(ws + OFF_PSGW);
        for (int i = gtid; i < 131072; i += gsz) psg[i] = f2bf(p.in[17][i]);
        bf16_t* cs = (bf16_t*)(ws + OFF_CS256); bf16_t* a256 = (bf16_t*)(ws + OFF_AS256); bf16_t* a1024 = (bf16_t*)(ws + OFF_AS1024);
        for (int idx = gtid; idx < 131072; idx += gsz) {
            { const int j = idx >> 8, k = idx & 255, m = ((j & 255) * k) & 255; const float ang = (float)m * (1.0f / 128.0f);
              cs[idx] = f2bf((j < 256 ? __builtin_amdgcn_cosf(ang * 0.5f) : __builtin_amdgcn_sinf(ang * 0.5f)) * 0.0625f); }
            { const int s = idx >> 9, kk = idx & 511, m = (s * (kk & 255)) & 255; const float ang = (float)m * (1.0f / 128.0f);
              a256[idx] = f2bf((kk < 256 ? __builtin_amdgcn_cosf(ang * 0.5f) : -__builtin_amdgcn_sinf(ang * 0.5f)) * 0.0625f); }
        }
        for (int idx = gtid; idx < 1048576; idx += gsz) { const int eo = idx >> 19, m = (idx >> 10) & 511, kk = idx & 1023, mm = ((2 * m + eo) * (kk & 511)) & 1023; const float ang = (float)mm * (1.0f / 1024.0f);
            a1024[idx] = f2bf((kk < 512 ? __builtin_amdgcn_cosf(ang) : -__builtin_amdgcn_sinf(ang)) * 0.03125f); }
        bf16_t* cseo = a1024 + 1048576;
        for (int idx = gtid; idx < 524288; idx += gsz) { const int eo = idx >> 18, j = (idx >> 9) & 511, kk = idx & 511, mm = ((j & 255) * (kk & 255)) & 255; const float ang = (float)mm * (1.0f / 256.0f);
            const float v = (j < 256 ? __builtin_amdgcn_cosf(ang) : __builtin_amdgcn_sinf(ang)) * 0.0625f; cseo[idx] = f2bf((kk >= 256 && eo) ? -v : v); }
    }
}

__device__ __forceinline__ void phase_init_rows(const Params& p) {
    const int lane = threadIdx.x & 63, wid = threadIdx.x >> 6;
    const float* mod = (const float*)(p.ws + OFF_MOD);
    const __amdgpu_buffer_rsrc_t rsx = __builtin_amdgcn_make_buffer_rsrc((void*)(p.ws + OFF_XW), 0, 0x7fffffff, 0x00020000), rsh = __builtin_amdgcn_make_buffer_rsrc((void*)(p.ws + OFF_H), 0, 0x7fffffff, 0x00020000);
    for (int row = blockIdx.x * 8 + wid; row < T; row += gridDim.x * 8) {
        const int cond = row < TC ? 0 : 1 + ((row - TC) >> 10);
        const float* src = row < TC ? p.in[0] + (size_t)row * 1024 : p.in[1] + (size_t)(row - TC) * 1024;
        const float* mc = mod + cond * 6144;
#pragma unroll
        for (int i = 0; i < 2; ++i) { const int col = i * 512 + lane * 8;
            const f32x4 v0 = __builtin_nontemporal_load((const f32x4*)(src + col)), v1 = __builtin_nontemporal_load((const f32x4*)(src + col + 4));
            u32x4 xo; xo.x = cvt_pk_bf16(v0[0], v0[1]); xo.y = cvt_pk_bf16(v0[2], v0[3]); xo.z = cvt_pk_bf16(v1[0], v1[1]); xo.w = cvt_pk_bf16(v1[2], v1[3]);
            __builtin_amdgcn_raw_buffer_store_b128(xo, rsx, (unsigned)((row * 1024 + col) * 2), 0, 18);
            const f32x4 sh0 = *(const f32x4*)(mc + col), sh1 = *(const f32x4*)(mc + col + 4), sc0 = *(const f32x4*)(mc + 1024 + col), sc1 = *(const f32x4*)(mc + 1024 + col + 4);
            const f32x4 h0 = v0 * (1.0f + sc0) + sh0, h1 = v1 * (1.0f + sc1) + sh1;
            u32x4 ho; ho.x = cvt_pk_bf16(h0[0], h0[1]); ho.y = cvt_pk_bf16(h0[2], h0[3]); ho.z = cvt_pk_bf16(h1[0], h1[1]); ho.w = cvt_pk_bf16(h1[2], h1[3]);
            __builtin_amdgcn_raw_buffer_store_b128(ho, rsh, (unsigned)((row * 1024 + col) * 2), 0, 18); }
    }
}

__device__ __forceinline__ void lru_unit(const int wv, const Params& p, const int j, const int ct, const int hd, const bool stage_w, unsigned char* lds) {
    const int t = fresh_tid(wv);
    const int w = t >> 6, lane = t & 63, fr = lane & 15, fq = lane >> 4;
    unsigned char* ws = p.ws; asm volatile("" : "+s"(ws));
    const GAS bf16_t* proj = (const GAS bf16_t*)(ws + OFF_PROJ);
    const GAS float* pp = (const GAS float*)(ws + OFF_PP);
    bf16_t* XA = (bf16_t*)lds;
    bf16_t* XC = (bf16_t*)(lds + 37440);
    bf16_t* WT = (bf16_t*)(lds + 74304);
    f32x2* AGG = (f32x2*)(lds + 111168);
    float* PRM = (float*)(lds + 128064);
    const bool is_ctx = ct < 32;
    const int row0 = ct * 256;
    const int seqlo = is_ctx ? row0 : TC + ((ct - 32) >> 2) * 1024, seqhi = seqlo + (is_ctx ? 256 : 1024);
    if (stage_w) for (int i = t; i < 704; i += NTHR) { const int r = i >> 6, c = i & 63, ch = hd * 64 + c; int off;
        if (r < 4) off = PP_CONVW + (j * 4 + r) * 512 + ch; else if (r == 4) off = PP_CONVB + j * 512 + ch;
        else { const int k = r - 5, dir = k & 1, which = k >> 1; off = (which == 0 ? PP_BA : which == 1 ? PP_BX : PP_SP) + (j * 2 + dir) * 512 + ch; }
        PRM[i] = pp[off]; }
    for (int idx = t; idx < 2080; idx += NTHR) { const int rr = idx >> 3, pc = idx & 7, grow = row0 + rr - 2;
        u32x4 v = (u32x4){0u, 0u, 0u, 0u};
        if (grow >= seqlo && grow < seqhi) v = *(const GAS u32x4*)(proj + (size_t)grow * 2048 + hd * 64 + pc * 8);
        *(u32x4*)((unsigned char*)XA + rr * 144 + pc * 16) = v; }
    if (stage_w) { const GAS bf16_t* pwt = (const GAS bf16_t*)(ws + OFF_PWT) + (size_t)(j * 8 + hd) * 16384;
#pragma unroll
      for (int i = 0; i < 4; ++i) { const int pc = t + NTHR * i, row = pc >> 3, c8 = pc & 7;
          *(u32x4*)((unsigned char*)WT + row * 144 + c8 * 16) = *(const GAS u32x4*)(pwt + row * 64 + c8 * 8); } }
    __syncthreads();
#pragma unroll 1
    for (int nt = 0; nt < 4; ++nt) { const int cl = nt * 16 + fr;
        const float c0 = PRM[cl], c1 = PRM[64 + cl], c2 = PRM[128 + cl], c3 = PRM[192 + cl], cb = PRM[256 + cl];
#pragma unroll
        for (int mt = 0; mt < 2; ++mt) { const int pb = 32 * w + 16 * mt + 4 * fq; float xv[7];
#pragma unroll
            for (int r = 0; r < 7; ++r) xv[r] = bf2f(XA[(pb + r) * 72 + cl]);
#pragma unroll
            for (int jj = 0; jj < 4; ++jj) XC[(pb + jj) * 72 + cl] = f2bf(cb + c0 * xv[jj] + c1 * xv[jj + 1] + c2 * xv[jj + 2] + c3 * xv[jj + 3]); } }
    __syncthreads();
    bf16x8 af[2][2];
#pragma unroll
    for (int mt = 0; mt < 2; ++mt)
#pragma unroll
        for (int ks = 0; ks < 2; ++ks) af[mt][ks] = *(const bf16x8*)((const unsigned char*)XC + (32 * w + 16 * mt + fr) * 144 + (ks * 32 + fq * 8) * 2);
    GAS bf16_t* yab = (GAS bf16_t*)(ws + OFF_YAB);
    GAS float* outst = (GAS float*)p.out + (size_t)T * 1024;
    bf16_t* GAT = (bf16_t*)(lds + 37440);
    bf16_t* OUT = (bf16_t*)(lds + 37440 + 16384);
    __syncthreads();
#pragma unroll 1
    for (int nh = 0; nh < 2; ++nh) {
        float xc[2][2][4], hsum[2][2][4], pfv[2][2][4], pbv[2][2][4];
#pragma unroll
        for (int i = 0; i < 2; ++i) { const int pc = t + NTHR * i, row = pc >> 2, c16 = pc & 3;
            *(u32x4*)(GAT + row * 32 + c16 * 8) = *(const GAS u32x4*)(proj + (size_t)(row0 + row) * 2048 + 512 + hd * 64 + nh * 32 + c16 * 8); }
#pragma unroll
        for (int n2 = 0; n2 < 2; ++n2) { const int cl = (nh * 2 + n2) * 16 + fr;
            const float c0 = PRM[cl], c1 = PRM[64 + cl], c2 = PRM[128 + cl], c3 = PRM[192 + cl], cb = PRM[256 + cl];
#pragma unroll
            for (int mt = 0; mt < 2; ++mt) { const int pb = 32 * w + 16 * mt + 4 * fq; float xv[7];
#pragma unroll
                for (int r = 0; r < 7; ++r) xv[r] = bf2f(XA[(pb + r) * 72 + cl]);
#pragma unroll
                for (int jj = 0; jj < 4; ++jj) { xc[mt][n2][jj] = cb + c0 * xv[jj] + c1 * xv[jj + 1] + c2 * xv[jj + 2] + c3 * xv[jj + 3]; hsum[mt][n2][jj] = 0.f;
                    pfv[mt][n2][jj] = 0.f; pbv[mt][n2][jj] = 0.f; } } }
#pragma unroll 1
        for (int dir = 0; dir < 2; ++dir) {
            const bool rev = dir != 0;
            float av[2][2][4], uv[2][2][4];
#pragma unroll
            for (int n2 = 0; n2 < 2; ++n2) { const int cl = (nh * 2 + n2) * 16 + fr;
                const float ba = PRM[(5 + dir) * 64 + cl], bx = PRM[(7 + dir) * 64 + cl], sp = PRM[(9 + dir) * 64 + cl];
                bf16x8 wa[2], wx[2];
#pragma unroll
                for (int ks = 0; ks < 2; ++ks) { wa[ks] = *(const bf16x8*)((const unsigned char*)WT + (((dir * 2 + 0) * 64 + cl) * 72 + ks * 32 + fq * 8) * 2);
                    wx[ks] = *(const bf16x8*)((const unsigned char*)WT + (((dir * 2 + 1) * 64 + cl) * 72 + ks * 32 + fq * 8) * 2); }
#pragma unroll
                for (int mt = 0; mt < 2; ++mt) { f32x4 ar = (f32x4){0.f, 0.f, 0.f, 0.f}, ai = (f32x4){0.f, 0.f, 0.f, 0.f};
#pragma unroll
                    for (int ks = 0; ks < 2; ++ks) { ar = __builtin_amdgcn_mfma_f32_16x16x32_bf16(af[mt][ks], wa[ks], ar, 0, 0, 0); ai = __builtin_amdgcn_mfma_f32_16x16x32_bf16(af[mt][ks], wx[ks], ai, 0, 0, 0); }
#pragma unroll
                    for (int q = 0; q < 4; ++q) { const float arq = rev ? ar[3 - q] : ar[q], aiq = rev ? ai[3 - q] : ai[q], xq = rev ? xc[mt][n2][3 - q] : xc[mt][n2][q];
                        const float r = sigmoidf_(arq + ba), ig = sigmoidf_(aiq + bx);
                        const float la = -8.0f * r * sp; const float a_ = fexp(la); av[mt][n2][q] = a_; uv[mt][n2][q] = __builtin_amdgcn_sqrtf(1.0f - a_ * a_) * (ig * xq); } } }
#pragma unroll
            for (int mt = 0; mt < 2; ++mt)
#pragma unroll
                for (int n2 = 0; n2 < 2; ++n2) { float A = av[mt][n2][0], U = uv[mt][n2][0];
#pragma unroll
                    for (int q = 1; q < 4; ++q) { U = av[mt][n2][q] * U + uv[mt][n2][q]; A *= av[mt][n2][q]; }
                    AGG[(8 * w + 4 * mt + fq) * 33 + n2 * 16 + fr] = (f32x2){A, U}; }
            __syncthreads();
            {
                const int seg = rev ? 63 - lane : lane;
#pragma unroll
                for (int k = 0; k < 4; ++k) { const int c = w * 4 + k; const f32x2 au = AGG[seg * 33 + c]; float A = au.x, U = au.y;
#pragma unroll
                    for (int d = 1; d < 64; d <<= 1) { const float Ap = __int_as_float(__builtin_amdgcn_ds_bpermute(((lane - d) & 63) << 2, __float_as_int(A))), Up = __int_as_float(__builtin_amdgcn_ds_bpermute(((lane - d) & 63) << 2, __float_as_int(U)));
                        if (lane >= d) { U = A * Up + U; A = A * Ap; } }
                    float Pin = __int_as_float(__builtin_amdgcn_ds_bpermute(((lane - 1) & 63) << 2, __float_as_int(A))), Hin = __int_as_float(__builtin_amdgcn_ds_bpermute(((lane - 1) & 63) << 2, __float_as_int(U)));
                    if (lane == 0) { Pin = 1.f; Hin = 0.f; }
                    AGG[seg * 33 + c] = (f32x2){Pin, Hin};
                    if (lane == 63) { const int chg = hd * 64 + nh * 32 + c;
                        if (is_ctx) outst[((ct * 2 + j) * 2 + dir) * 512 + chg] = U;
                        else { unsigned long long* agg = (unsigned long long*)(ws + OFF_AGG); const int sb = (ct - 32) >> 2, cch = (ct - 32) & 3;
                            __hip_atomic_store(agg + (((sb * 4 + cch) * 2 + dir) * 512) + chg, ((unsigned long long)__float_as_uint(U) << 32) | __float_as_uint(A), __ATOMIC_RELAXED, __HIP_MEMORY_SCOPE_AGENT); } } } }
            __syncthreads();
#pragma unroll
            for (int mt = 0; mt < 2; ++mt)
#pragma unroll
                for (int n2 = 0; n2 < 2; ++n2) { const f32x2 cin = AGG[(8 * w + 4 * mt + fq) * 33 + n2 * 16 + fr]; float P = cin.x, hh = cin.y; float hq[4], pq[4];
#pragma unroll
                    for (int q = 0; q < 4; ++q) { hh = av[mt][n2][q] * hh + uv[mt][n2][q]; P *= av[mt][n2][q]; hq[q] = hh; pq[q] = P; }
#pragma unroll
                    for (int jj = 0; jj < 4; ++jj) { hsum[mt][n2][jj] += rev ? hq[3 - jj] : hq[jj];
                        const float pv = rev ? pq[3 - jj] : pq[jj]; pfv[mt][n2][jj] = rev ? pfv[mt][n2][jj] : pv; pbv[mt][n2][jj] = rev ? pv : pbv[mt][n2][jj]; } }
            __syncthreads();
        }
        float cfv[2], cbv[2]; cfv[0] = cfv[1] = cbv[0] = cbv[1] = 0.f;
        if (!is_ctx) {
            const int sb = (ct - 32) >> 2, cch = (ct - 32) & 3;
            unsigned* lcnt = (unsigned*)(ws + OFF_LCNT) + ((((j * 4 + sb) * 8 + hd) * 2 + nh) * 16);
            asm volatile("s_waitcnt vmcnt(0)" ::: "memory");
            __syncthreads();
            if (t == 0) __hip_atomic_fetch_add(lcnt, 1u, __ATOMIC_RELAXED, __HIP_MEMORY_SCOPE_AGENT);
            if (w == 0) { unsigned sp = 0;
                while ((unsigned)__builtin_amdgcn_readfirstlane(__hip_atomic_load(lcnt, __ATOMIC_RELAXED, __HIP_MEMORY_SCOPE_AGENT)) < 4u) { __builtin_amdgcn_s_sleep(2); if (++sp > (1u << 22)) break; }
                __builtin_amdgcn_fence(__ATOMIC_ACQUIRE, "agent"); }
            asm volatile("s_waitcnt vmcnt(0) lgkmcnt(0)" ::: "memory"); __syncthreads();
            const unsigned long long* agg = (const unsigned long long*)(ws + OFF_AGG);
#pragma unroll
            for (int n2 = 0; n2 < 2; ++n2) { const int ch = hd * 64 + (nh * 2 + n2) * 16 + fr;
                float hf = pp[PP_STATE + ((sb * 2 + j) * 2 + 0) * 512 + ch], hb = pp[PP_STATE + ((sb * 2 + j) * 2 + 1) * 512 + ch];
                unsigned long long af_[4], ab_[4];
#pragma unroll
                for (int cc = 0; cc < 4; ++cc) { af_[cc] = __hip_atomic_load(agg + (((sb * 4 + cc) * 2 + 0) * 512) + ch, __ATOMIC_RELAXED, __HIP_MEMORY_SCOPE_AGENT); ab_[cc] = __hip_atomic_load(agg + (((sb * 4 + cc) * 2 + 1) * 512) + ch, __ATOMIC_RELAXED, __HIP_MEMORY_SCOPE_AGENT); }
#pragma unroll
                for (int cc = 0; cc < 4; ++cc) { const float A = __uint_as_float((unsigned)af_[cc]), U = __uint_as_float((unsigned)(af_[cc] >> 32)); hf = cc < cch ? A * hf + U : hf; }
#pragma unroll
                for (int cc = 3; cc >= 0; --cc) { const float A = __uint_as_float((unsigned)ab_[cc]), U = __uint_as_float((unsigned)(ab_[cc] >> 32)); hb = cc > cch ? A * hb + U : hb; }
                cfv[n2] = hf; cbv[n2] = hb; }
        }
#pragma unroll
        for (int mt = 0; mt < 2; ++mt)
#pragma unroll
            for (int n2 = 0; n2 < 2; ++n2)
#pragma unroll
                for (int jj = 0; jj < 4; ++jj) { const int pos = 32 * w + 16 * mt + 4 * fq + jj, cl2 = n2 * 16 + fr;
                    const float hv = hsum[mt][n2][jj] + pfv[mt][n2][jj] * cfv[n2] + pbv[mt][n2][jj] * cbv[n2];
                    OUT[pos * 32 + cl2] = f2bf(hv * bf2f(GAT[pos * 32 + cl2])); }
        __syncthreads();
#pragma unroll
        for (int i = 0; i < 2; ++i) { const int pc = t + NTHR * i, row = pc >> 2, c16 = pc & 3;
            *(GAS u32x4*)(yab + (size_t)(row0 + row) * 1024 + hd * 64 + nh * 32 + c16 * 8) = *(const u32x4*)(OUT + row * 32 + c16 * 8); }
        __syncthreads();
    }
}

__device__ __forceinline__ void lru_fix_unit(const int wv, const Params& p, const int j, const int lc, const int hd) {
    const int t = fresh_tid(wv); unsigned char* ws = p.ws; asm volatile("" : "+s"(ws));
    const int sb = lc >> 2, c = lc & 3, ch = hd * 64 + (t & 15) * 4, r0 = t >> 4;
    const float* agg = (const float*)(ws + OFF_AGG);
    f32x4 cf, cb;
#pragma unroll
    for (int e = 0; e < 4; ++e) {
        float hf = ((const GAS float*)(ws + OFF_PP))[PP_STATE + ((sb * 2 + j) * 2 + 0) * 512 + ch + e];
        for (int cc = 0; cc < c; ++cc) { const f32x2 au = *(const f32x2*)(agg + ((((sb * 4 + cc) * 2 + 0) * 512) + ch + e) * 2); hf = au.x * hf + au.y; }
        float hb = ((const GAS float*)(ws + OFF_PP))[PP_STATE + ((sb * 2 + j) * 2 + 1) * 512 + ch + e];
        for (int cc = 3; cc > c; --cc) { const f32x2 au = *(const f32x2*)(agg + ((((sb * 4 + cc) * 2 + 1) * 512) + ch + e) * 2); hb = au.x * hb + au.y; }
        cf[e] = hf; cb[e] = hb; }
    const float* S1 = (const float*)(ws + OFF_F1); const float* PF = (const float*)(ws + OFF_F1 + 8388608); const float* PBk = (const float*)(ws + OFF_F1 + 16777216);
    const bf16_t* proj = (const bf16_t*)(ws + OFF_PROJ); bf16_t* yab = (bf16_t*)(ws + OFF_YAB);
#pragma unroll
    for (int i = 0; i < 8; ++i) { const int lrow = lc * 256 + r0 + 32 * i; const size_t o = (size_t)lrow * 512 + ch;
        const f32x4 s1 = *(const f32x4*)(S1 + o), pf = *(const f32x4*)(PF + o), pb = *(const f32x4*)(PBk + o);
        const u32x2 gw = *(const u32x2*)(proj + (size_t)(TC + lrow) * 2048 + 512 + ch);
        const f32x4 hv = s1 + pf * cf + pb * cb;
        u32x2 w; w.x = cvt_pk_bf16(hv[0] * bf2f(gw.x & 0xffffu), hv[1] * bf2f(gw.x >> 16)); w.y = cvt_pk_bf16(hv[2] * bf2f(gw.y & 0xffffu), hv[3] * bf2f(gw.y >> 16));
        *(u32x2*)(yab + (size_t)(TC + lrow) * 1024 + ch) = w; }
}

__device__ __forceinline__ void sgu_unit(const int wv, const Params& p, const int j, const int c, const int g, const bool stage_w, unsigned char* lds) {
    const int t = fresh_tid(wv);
    const int w = t >> 6, lane = t & 63, fr = lane & 15, fq = lane >> 4;
    unsigned char* ws = p.ws; asm volatile("" : "+s"(ws));
    const GAS bf16_t* proj = (const GAS bf16_t*)(ws + OFF_PROJ); GAS bf16_t* yab = (GAS bf16_t*)(ws + OFF_YAB);
    bf16_t* VT = (bf16_t*)lds;
    bf16_t* WS = (bf16_t*)(lds + 34816);
    f32x2* ST = (f32x2*)(lds + 69632);
    float* SP = (float*)(lds + 70656);
    const int row0 = c * 128;
    { const int l16 = t & 15, rsub = t >> 4; float eps = LN_EPS; asm volatile("" : "+s"(eps));
      u32x4 raw[4][4];
#pragma unroll
      for (int ps = 0; ps < 4; ++ps) { const GAS bf16_t* vp = proj + (size_t)(row0 + ps * 32 + rsub) * 2048 + 1536;
#pragma unroll
          for (int i = 0; i < 4; ++i) raw[ps][i] = *(const GAS u32x4*)(vp + (i * 16 + l16) * 8); }
#pragma unroll
      for (int ps = 0; ps < 4; ++ps) { float s = 0.f;
#pragma unroll
          for (int i = 0; i < 4; ++i)
#pragma unroll
              for (int e2 = 0; e2 < 4; ++e2) s += bf2f(raw[ps][i][e2] & 0xffffu) + bf2f(raw[ps][i][e2] >> 16);
          s += lane_xor(s, lane, 1); s += lane_xor(s, lane, 2); s += lane_xor(s, lane, 4); s += lane_xor(s, lane, 8);
          const float mean = s * (1.0f / 512.0f); float q = 0.f;
#pragma unroll
          for (int i = 0; i < 4; ++i)
#pragma unroll
              for (int e2 = 0; e2 < 4; ++e2) { const float a = bf2f(raw[ps][i][e2] & 0xffffu) - mean, b = bf2f(raw[ps][i][e2] >> 16) - mean; q += a * a + b * b; }
          q += lane_xor(q, lane, 1); q += lane_xor(q, lane, 2); q += lane_xor(q, lane, 4); q += lane_xor(q, lane, 8);
          if (l16 == 0) ST[ps * 32 + rsub] = (f32x2){mean, __builtin_amdgcn_rsqf(q * (1.0f / 512.0f) + eps)}; } }
    if (stage_w) { const GAS bf16_t* wsrc = (const GAS bf16_t*)(ws + OFF_PSGW) + (size_t)((j * 4 + g) * 16384);
#pragma unroll
      for (int i = 0; i < 4; ++i) { const int pc = t + NTHR * i, row = pc >> 4, c8 = pc & 15;
          *(u32x4*)((unsigned char*)WS + row * 272 + c8 * 16) = *(const GAS u32x4*)(wsrc + row * 128 + c8 * 8); }
      const GAS float* pp = (const GAS float*)(ws + OFF_PP);
      if (t < 384) { const int r = t >> 7, c = t & 127; SP[t] = pp[(r == 0 ? PP_SGLG + j * 512 + g * 128 : r == 1 ? PP_SGLB + j * 512 + g * 128 : PP_SGBS + (j * 4 + g) * 128) + c]; } }
    __syncthreads();
    { const int q = t >> 2, d0 = (t & 3) * 32; const f32x2 st = ST[q]; const GAS bf16_t* vp = proj + (size_t)(row0 + q) * 2048 + 1536 + g * 128 + d0;
      const float* lg = SP + d0; const float* lb = SP + 128 + d0;
#pragma unroll
      for (int i = 0; i < 4; ++i) { const u32x4 raw = *(const GAS u32x4*)(vp + i * 8);
#pragma unroll
          for (int e = 0; e < 4; ++e) { const int d = i * 8 + e * 2;
              const float a = (bf2f(raw[e] & 0xffffu) - st.x) * st.y * lg[d] + lb[d], b = (bf2f(raw[e] >> 16) - st.x) * st.y * lg[d + 1] + lb[d + 1];
              VT[(d0 + d) * 136 + q] = f2bf(a); VT[(d0 + d + 1) * 136 + q] = f2bf(b); } } }
    __syncthreads();
    bf16x8 yf[4];
#pragma unroll
    for (int ks = 0; ks < 4; ++ks) yf[ks] = *(const bf16x8*)((const unsigned char*)WS + ((16 * w + fr) * 136 + ks * 32 + fq * 8) * 2);
    const int pp = 16 * w + fr, row = row0 + pp;
    const float bsv = SP[256 + pp];
#pragma unroll
    for (int dt = 0; dt < 8; ++dt) { f32x4 acc = (f32x4){0.f, 0.f, 0.f, 0.f};
#pragma unroll
        for (int ks = 0; ks < 4; ++ks) { const bf16x8 xf = *(const bf16x8*)((const unsigned char*)VT + ((16 * dt + fr) * 136 + ks * 32 + fq * 8) * 2);
            acc = __builtin_amdgcn_mfma_f32_16x16x32_bf16(xf, yf[ks], acc, 0, 0, 0); }
        const int d = 16 * dt + 4 * fq;
        const u32x2 gu = *(const GAS u32x2*)(proj + (size_t)row * 2048 + 1024 + g * 128 + d);
        u32x2 o; o.x = cvt_pk_bf16((acc[0] + bsv) * bf2f(gu.x & 0xffffu), (acc[1] + bsv) * bf2f(gu.x >> 16)); o.y = cvt_pk_bf16((acc[2] + bsv) * bf2f(gu.y & 0xffffu), (acc[3] + bsv) * bf2f(gu.y >> 16));
        *(GAS u32x2*)(yab + (size_t)row * 1024 + 512 + g * 128 + d) = o; }
    __syncthreads();
}

#define XB_TMO      128
#define XB_XCNT(j)  (256  + 64 * (j))
#define XB_XSUB(j)  (1280 + 64 * (j))
#define XB_XGEN(j)  (2304 + 64 * (j))
#define XB_TOP      3328
#define XB_TOPGEN   3392
#define XCD_BAR_WORDS 3456
#define XB_SPIN_CAP (1u << 22)
__device__ __forceinline__ unsigned xb_ld(unsigned* p)              { return __hip_atomic_load(p, __ATOMIC_RELAXED, __HIP_MEMORY_SCOPE_AGENT); }
__device__ __forceinline__ unsigned xb_add(unsigned* p, unsigned v) { return __hip_atomic_fetch_add(p, v, __ATOMIC_RELAXED, __HIP_MEMORY_SCOPE_AGENT); }
__device__ __forceinline__ unsigned xb_xcc_id() { return (unsigned)__builtin_amdgcn_s_getreg((3 << 11) | 20) & 0xFu; }
#define XB_SPIN(cond, bar) do { unsigned _sp = 0; while (cond) { __builtin_amdgcn_s_sleep(1); \
    if ((++_sp & 255u) == 0u) { if (xb_ld(&(bar)[XB_TMO])) break; if (_sp > XB_SPIN_CAP) { atomicAdd(&(bar)[XB_TMO], 1u); break; } } } } while (0)
__device__ __forceinline__ void xcd_barrier_complete(unsigned* bar, unsigned x, unsigned& nloc, unsigned& nx) {
    const unsigned G = gridDim.x * gridDim.y * gridDim.z;
    unsigned sum, cnt, mine, sp = 0u;
    for (;;) {
        sum = 0u; cnt = 0u; mine = 0u;
#pragma unroll
        for (unsigned j = 0; j < 16; ++j) { const unsigned c = xb_ld(&bar[XB_XCNT(j)]); sum += c; cnt += (c > 0u) ? 1u : 0u; mine = (j == x) ? c : mine; }
        if (sum == G) break;
        __builtin_amdgcn_s_sleep(1);
        if ((++sp & 255u) == 0u) { if (xb_ld(&bar[XB_TMO])) break; if (sp > XB_SPIN_CAP) { atomicAdd(&bar[XB_TMO], 1u); break; } }
    }
    nloc = mine > 0u ? mine : 1u; nx = cnt > 0u ? cnt : 1u;
}
__device__ __forceinline__ void xcd_barrier(const int wv, unsigned* bar, volatile LAS unsigned* st) {
    asm volatile("s_waitcnt vmcnt(0)" ::: "memory");
    __syncthreads();
    if (fresh_tid(wv) == 0) {
        const unsigned x = xb_xcc_id();
        __builtin_amdgcn_s_waitcnt(0);
        unsigned nloc = st[0], nx = st[1];
        if (nloc == 0u) { xcd_barrier_complete(bar, x, nloc, nx); st[0] = nloc; st[1] = nx; }
        const unsigned old = xb_add(&bar[XB_XSUB(x)], 1u);
        const unsigned gen = old / nloc;
        if (old + 1u == (gen + 1u) * nloc) {
            __builtin_amdgcn_fence(__ATOMIC_RELEASE, "agent");
            asm volatile("s_waitcnt vmcnt(0)" ::: "memory");
            const unsigned og = xb_add(&bar[XB_TOP], 1u);
            const unsigned tg = og / nx;
            if (og + 1u == (tg + 1u) * nx) xb_add(&bar[XB_TOPGEN], 1u);
            else XB_SPIN(xb_ld(&bar[XB_TOPGEN]) == tg, bar);
            __builtin_amdgcn_fence(__ATOMIC_ACQUIRE, "agent");
            xb_add(&bar[XB_XGEN(x)], 1u);
            asm volatile("s_waitcnt vmcnt(0)" ::: "memory");
        } else {
            XB_SPIN(xb_ld(&bar[XB_XGEN(x)]) == gen, bar);
            __builtin_amdgcn_fence(__ATOMIC_ACQUIRE, "agent");
            asm volatile("s_waitcnt vmcnt(0)" ::: "memory");
        }
    }
    __syncthreads();
}

__global__ void __launch_bounds__(NTHR, 2) fwd_megakernel(Params p) {
    extern __shared__ __attribute__((aligned(16))) unsigned char shm[];
    cg::grid_group grid = cg::this_grid();
    LAS unsigned char* lds = (LAS unsigned char*)shm;
    unsigned char* ws = p.ws;
    const int lo = p.lo, hi = p.hi;
    const int wv = __builtin_amdgcn_readfirstlane(threadIdx.x >> 6);
    if (threadIdx.x < 4) ((LAS unsigned*)(lds + 131072))[threadIdx.x] = 0u;
    __syncthreads();
    if (threadIdx.x == 0) (void)xb_add(&((unsigned*)(ws + OFF_BAR))[XB_XCNT(xb_xcc_id())], 1u);
    int pc = 0;
#define RUN (pc >= lo && pc < hi)
#define SEAM do { if (pc >= lo && pc + 1 < hi) xcd_barrier(wv, (unsigned*)(ws + OFF_BAR), (volatile LAS unsigned*)(lds + 131072)); ++pc; } while (0)

    if (RUN) phase0(p, (float*)shm);
    if (lo < 0) grid.sync();
    SEAM;
    if (RUN) phase_init_rows(p);
    SEAM;
#pragma unroll 1
    for (int l = 0; l < 4; ++l) {
        const int j = l >> 1; const bool even = (l & 1) == 0;
#pragma unroll 1
        for (int sub = 0; sub < 2; ++sub) {
            asm volatile("" : "+s"(ws));
            int G = gridDim.x, bid = blockIdx.x; asm volatile("" : "+s"(G), "+s"(bid));
            bf16_t* Hb = (bf16_t*)(ws + OFF_H); bf16_t* PROJ = (bf16_t*)(ws + OFF_PROJ); bf16_t* YAB = (bf16_t*)(ws + OFF_YAB); bf16_t* F1 = (bf16_t*)(ws + OFF_F1);
            bf16_t* XW = (bf16_t*)(ws + OFF_XW); const float* MOD = (const float*)(ws + OFF_MOD);
            if (sub == 0) {
                if (even) {
                    if (RUN) { pg8::SchedDense S{Hb, (const bf16_t*)(ws + OFF_WIN) + (size_t)j * 2097152, 1024, 1024, 64, 8, G, bid, 192, PROJ, 2048};
                        pg8::gemm_phase<3, true>(wv, lds, 1024, 1024, 1024, S, pg8::EpiBf<1>{}); }
                    SEAM;
                    if (RUN) {
                        { int hprev = -1; for (int u = bid; u < 384; u += G) { const int hd = u & 7; lru_unit(wv, p, j, u < 128 ? 32 + (u >> 3) : (u - 128) >> 3, hd, hd != hprev, shm); hprev = hd; } }
                        { const int half = G >> 1;
                          if (bid >= half) { int gprev = -1; for (int u = bid - half; u < 384; u += G - half) { const int k = u >> 3, g = k & 3; sgu_unit(wv, p, j, (k >> 2) * 8 + (u & 7), g, g != gprev, shm); gprev = g; } } }
                    }
                    SEAM;
                } else {
                    if (RUN) {
#pragma unroll 1
                        for (int part = 0; part < 2; ++part) {
                            const int half = G >> 1;
                            pg8::SchedD1 S{(const bf16_t*)(ws + OFF_CS256), (const bf16_t*)(ws + OFF_AS1024) + 1048576, Hb, PROJ, part == 0 ? G : G - half, part == 0 ? bid : bid - half, part};
                            const int kk = part == 0 ? 512 : 256;
                            pg8::gemm_phase<4, true>(wv, lds, kk, 1024, kk, S, pg8::EpiBf<0>{}, part == 0 ? 4 : (1 << 30), part == 0 ? (size_t)(512 * 1024 - 256) * 2 : (size_t)0);
                        } }
                    SEAM;
                    if (RUN) {
#pragma unroll 1
                        for (int part = 0; part < 2; ++part) {
                            pg8::SchedD2 S{(const bf16_t*)(ws + (part == 0 ? OFF_AS1024 : OFF_AS256)), PROJ, YAB, G, part == 0 ? bid : (bid + G - 64) % G, part};
                            const int kk = part == 0 ? 1024 : 512;
                            pg8::gemm_phase<4, true>(wv, lds, kk, part == 0 ? 2048 : 512, kk, S, pg8::EpiBf<0>{});
                        } }
                    SEAM;
                }
            } else {
                if (RUN) { pg8::SchedDense S{Hb, (const bf16_t*)(ws + OFF_W1) + (size_t)l * 4194304, 1024, 1024, 48, 16, G, bid, 256, F1, 4096};
                    pg8::gemm_phase<4, true>(wv, lds, 1024, 1024, 1024, S, pg8::EpiBf<2>{}); }
                SEAM;
            }
            if (RUN) {
                const bf16_t* A = sub == 0 ? YAB : F1;
                const bf16_t* Bt = sub == 0 ? (even ? (const bf16_t*)(ws + OFF_WOAB) : (const bf16_t*)(ws + OFF_WOC)) + (size_t)j * 1048576 : (const bf16_t*)(ws + OFF_W2) + (size_t)l * 4194304;
                const int K = sub == 0 ? 1024 : 4096;
                const bool final_ln = (l == 3 && sub == 1);
                const float* modn = final_ln ? nullptr : (sub == 0 ? MOD + l * 30720 + 3072 : MOD + (l + 1) * 30720);
                pg8::SchedDense S{A, Bt, K, K, 64, 4, G, bid, 192, YAB, 1024};
                pg8::EpiResidLn E{(const float*)(ws + OFF_PP) + PP_LNG + (l * 2 + sub) * 1024, (const float*)(ws + OFF_PP) + PP_LNB + (l * 2 + sub) * 1024, MOD + l * 30720 + (sub == 0 ? 2048 : 5120), modn, XW, p.out, Hb,
                                  (unsigned long long*)(ws + OFF_XCH), (unsigned*)(ws + OFF_CNT) + (l * 2 + sub) * 64 * 64};
                pg8::gemm_phase<3, false>(wv, lds, K, K, K, S, E);
            }
            SEAM;
        }
    }
#undef RUN
#undef SEAM
}

constexpr int N_PHASES = 2 + 4 * 5;

extern "C" void kernel_launch(void* const* d_in, const int* in_sizes, int n_in, void* d_out, int out_size, void* d_ws, size_t ws_size, hipStream_t stream) {
    static int grid_blocks = 0;
    if (!grid_blocks) {
        int dev = 0, cus = 0, per_cu = 0;
        hipGetDevice(&dev);
        hipDeviceGetAttribute(&cus, hipDeviceAttributeMultiprocessorCount, dev);
        if (hipFuncSetAttribute((const void*)fwd_megakernel, hipFuncAttributeMaxDynamicSharedMemorySize, LDS_BYTES) != hipSuccess) fprintf(stderr, "hipFuncSetAttribute failed\n");
        if (hipOccupancyMaxActiveBlocksPerMultiprocessor(&per_cu, (const void*)fwd_megakernel, NTHR, LDS_BYTES) != hipSuccess || per_cu < 1) { fprintf(stderr, "occupancy query: %d\n", per_cu); per_cu = 1; }
        (void)hipGetLastError();
        if (cus <= 0) cus = 256;
        grid_blocks = cus;
        if (ws_size < OFF_END) fprintf(stderr, "workspace too small: %zu < %zu\n", ws_size, (size_t)OFF_END);
    }
    (void)hipMemsetAsync((unsigned char*)d_ws + OFF_BAR, 0, 16384 + 131072 + 8192, stream);
    Params p{};
    for (int i = 0; i < 25; ++i) p.in[i] = (const float*)d_in[i];
    p.out = (float*)d_out; p.ws = (unsigned char*)d_ws;
#if PER_PHASE_LAUNCH
    for (int ph = 0; ph < N_PHASES; ++ph) {
        p.lo = ph; p.hi = ph + 1;
        void* args[] = {&p};
        hipError_t e = hipLaunchCooperativeKernel((const void*)fwd_megakernel, dim3(grid_blocks), dim3(NTHR), args, LDS_BYTES, stream);
        if (e != hipSuccess) { fprintf(stderr, "cooperative launch failed: %s (grid %d)\n", hipGetErrorString(e), grid_blocks); break; }
    }
#else
    p.lo = 0; p.hi = N_PHASES;
    void* args[] = {&p};
    hipError_t e = hipLaunchCooperativeKernel((const void*)fwd_megakernel, dim3(grid_blocks), dim3(NTHR), args, LDS_BYTES, stream);
    if (e != hipSuccess) fprintf(stderr, "cooperative launch failed: %s (grid %d)\n", hipGetErrorString(e), grid_blocks);
#endif
}
```

```cpp
#include <hip/hip_runtime.h>
#include <hip/hip_cooperative_groups.h>
#include <cstdio>
namespace cg = cooperative_groups;

#ifndef PER_PHASE_LAUNCH
#define PER_PHASE_LAUNCH 0
#endif

#define LAS __attribute__((address_space(3)))
#define GAS __attribute__((address_space(1)))
typedef unsigned short bf16_t;
typedef short bf16x8 __attribute__((ext_vector_type(8)));
typedef float f32x4 __attribute__((ext_vector_type(4)));
typedef float f32x2 __attribute__((ext_vector_type(2)));
typedef unsigned u32x4 __attribute__((ext_vector_type(4)));
typedef unsigned u32x2 __attribute__((ext_vector_type(2)));

constexpr int T = 12288, TC = 8192, D = 1024, DFF = 4096;
constexpr int NTHR = 512;
constexpr int LDS_BYTES = 131072 + 16;
constexpr float ALPHA = 1.681792830507429f;
constexpr float LN_EPS = 1e-5f;

constexpr size_t OFF_WIN = 0;
constexpr size_t OFF_WOAB = OFF_WIN + 8388608;
constexpr size_t OFF_WOC = OFF_WOAB + 4194304;
constexpr size_t OFF_W1 = OFF_WOC + 4194304;
constexpr size_t OFF_W2 = OFF_W1 + 33554432;
constexpr size_t OFF_MOD = OFF_W2 + 33554432;
constexpr size_t OFF_CS256 = OFF_MOD + 491520;
constexpr size_t OFF_AS256 = OFF_CS256 + 262144;
constexpr size_t OFF_AS1024 = OFF_AS256 + 262144;
constexpr size_t OFF_AGG = OFF_AS1024 + 4194304;
constexpr size_t OFF_TAB = OFF_AGG + 131072;
constexpr size_t OFF_BAR = OFF_TAB + 256;
constexpr size_t OFF_CNT = OFF_BAR + 16384;
constexpr size_t OFF_LCNT = OFF_CNT + 131072;
constexpr size_t OFF_XCH = OFF_LCNT + 8192;
constexpr size_t OFF_PP = OFF_XCH + 393216;
constexpr int PP_CONVW = 0, PP_CONVB = 4096, PP_BA = 5120, PP_BX = 7168, PP_SP = 9216, PP_SGLG = 11264, PP_SGLB = 12288, PP_SGBS = 13312, PP_LNG = 14336, PP_LNB = 22528, PP_STATE = 30720, PP_END = 38912;
constexpr size_t OFF_PWT = OFF_PP + 155648;
constexpr size_t OFF_PSGW = OFF_PWT + 524288;
constexpr size_t OFF_XW = OFF_PSGW + 262144;
constexpr size_t OFF_H = OFF_XW + 50331648;
constexpr size_t OFF_PROJ = OFF_H + 25165824;
constexpr size_t OFF_YAB = OFF_PROJ + 50331648;
constexpr size_t OFF_F1 = OFF_YAB + 25165824;
constexpr size_t OFF_END = OFF_F1 + 100663296;

struct Params {
    const float* in[25];
    float* out;
    unsigned char* ws;
    int lo, hi;
};

__device__ __forceinline__ const float* tabp(const unsigned char* ws, int i) {
    const unsigned long long v = ((const unsigned long long*)(ws + OFF_TAB))[i];
    const unsigned lo = __builtin_amdgcn_readfirstlane((unsigned)v), hi = __builtin_amdgcn_readfirstlane((unsigned)(v >> 32));
    return (const float*)(((unsigned long long)hi << 32) | lo);
}
__device__ __forceinline__ int fresh_tid(int wv) { int l; asm volatile("v_mbcnt_lo_u32_b32 %0, -1, 0\n\tv_mbcnt_hi_u32_b32 %0, -1, %0" : "=v"(l)); return wv * 64 + l; }
__device__ __forceinline__ float bf2f(unsigned b) { return __uint_as_float(b << 16); }
__device__ __forceinline__ unsigned cvt_pk_bf16(float lo, float hi) { unsigned r; asm("v_cvt_pk_bf16_f32 %0, %1, %2" : "=v"(r) : "v"(lo), "v"(hi)); return r; }
__device__ __forceinline__ bf16_t f2bf(float x) { return (bf16_t)(cvt_pk_bf16(x, 0.f) & 0xffffu); }
__device__ __forceinline__ float fexp(float x) { return __builtin_amdgcn_exp2f(x * 1.4426950408889634f); }
__device__ __forceinline__ float flog(float x) { return __builtin_amdgcn_logf(x) * 0.6931471805599453f; }
__device__ __forceinline__ float sigmoidf_(float x) { return __builtin_amdgcn_rcpf(1.0f + fexp(-x)); }
__device__ __forceinline__ float lane_xor(float v, int lane, int o) { return __int_as_float(__builtin_amdgcn_ds_bpermute((lane ^ o) << 2, __float_as_int(v))); }
__device__ __forceinline__ float gelu_tanh(float x) { const float z = 1.5957691216057308f * (x + 0.044715f * x * x * x); return x * __builtin_amdgcn_rcpf(1.0f + fexp(-z)); }
__device__ __forceinline__ float wave_sum(float v, int lane) {
#pragma unroll
    for (int o = 32; o >= 1; o >>= 1) v += lane_xor(v, lane, o);
    return v;
}

namespace pg8 {
constexpr int BM = 256, BK = 64, HALF = 128, HTB = HALF * BK * 2, NXCD = 8, WGM = 8;
__device__ __forceinline__ int lds_byte(int r, int c) { const int st = (r >> 4) * 2 + (c >> 5), rr = r & 15, cc = c & 31, ob = rr * 64 + cc * 2; return st * 1024 + (ob ^ (((ob >> 9) & 1) << 5)); }
__device__ __forceinline__ void stage_rc(int b, int& R, int& C) { const int st = b / 1024, sb = b % 1024, swz = sb ^ (((sb >> 9) & 1) << 5); R = (st >> 1) * 16 + swz / 64; C = (st & 1) * 32 + (swz % 64) / 2; }
__device__ __forceinline__ int perm32(int rho) { const int n = rho >> 4, i = rho & 15; return 8 * (i >> 2) + 4 * n + (i & 3); }

struct Unit { const char* a; const char* b; bf16_t* o; float* x; const float* gate; int ldc; int flag; int pm, pn, cond; };

template <int ACT  > struct EpiBf {
    static constexpr bool PERM = true, AFTER_DRAIN = false;
    template <int MT> __device__ __forceinline__ void operator()(const f32x4 (&acc)[2][2][MT][2], const Unit& u, const int wv) const {
        const int lane = fresh_tid(wv) & 63, wr = wv >> 2, wc = wv & 3, fr = lane & 15, fq = lane >> 4;
        const int r0 = wr * (16 * MT) + fr;
        const __amdgpu_buffer_rsrc_t rs = __builtin_amdgcn_make_buffer_rsrc((void*)u.o, 0, 0x7fffffff, 0x00020000);
        const unsigned base = ((unsigned)r0 * (unsigned)u.ldc + (unsigned)(wc * 32 + 8 * fq)) * 2u;
#pragma unroll
        for (int ai = 0; ai < 2; ++ai)
#pragma unroll
            for (int m = 0; m < MT; ++m) {
                const unsigned rowp = base + (unsigned)(ai * (32 * MT) + m * 16) * (unsigned)u.ldc * 2u;
#pragma unroll
                for (int bj = 0; bj < 2; ++bj) {
                    f32x4 v0 = acc[ai][bj][m][0], v1 = acc[ai][bj][m][1];
                    if (ACT == 1) { if (u.flag) {
#pragma unroll
                        for (int j = 0; j < 4; ++j) { v0[j] = gelu_tanh(v0[j]); v1[j] = gelu_tanh(v1[j]); } } }
                    if (ACT == 2) {
#pragma unroll
                        for (int j = 0; j < 4; ++j) { const float a = fmaxf(v0[j], 0.f), b = fmaxf(v1[j], 0.f); v0[j] = a * a; v1[j] = b * b; } }
                    u32x4 w; w.x = cvt_pk_bf16(v0[0], v0[1]); w.y = cvt_pk_bf16(v0[2], v0[3]); w.z = cvt_pk_bf16(v1[0], v1[1]); w.w = cvt_pk_bf16(v1[2], v1[3]);
                    __builtin_amdgcn_raw_buffer_store_b128(w, rs, rowp + bj * HALF * 2, 0, 18);
                }
            }
    }
};
__device__ __forceinline__ int cond_of_row(int rg) { return rg < TC ? 0 : 1 + ((rg - TC) >> 10); }
struct EpiResidLn {
    static constexpr bool PERM = true, AFTER_DRAIN = true;
    const float* lng; const float* lnb; const float* gatebase; const float* modn; bf16_t* xw; float* outf; bf16_t* hb;
    unsigned long long* xbuf; unsigned* cnt;
    template <int MT> __device__ __forceinline__ void fused(f32x4 (&acc)[2][2][MT][2], const Unit& u, const int wv, LAS unsigned char* lds) const {
        constexpr int RT = 64 * MT, RH = 32 * MT, RW = 16 * MT;
        const int lane = fresh_tid(wv) & 63, wid = wv, wr = wv >> 2, wc = wv & 3, fr = lane & 15, fq = lane >> 4;
        const int colg0 = u.pn * BM + wc * 32 + 8 * fq;
        const int rg0 = u.pm * RT + wr * RW + fr;
        const int cond0 = cond_of_row(u.pm * RT); const bool uni = cond0 == cond_of_row(u.pm * RT + RT - 1);
#pragma unroll
        for (int bj = 0; bj < 2; ++bj) {
            const int cg = colg0 + bj * HALF;
            f32x4 g0 = *(const f32x4*)(gatebase + cond0 * 6144 + cg), g1 = *(const f32x4*)(gatebase + cond0 * 6144 + cg + 4);
            u32x4 xr[2][MT];
#pragma unroll
            for (int ai = 0; ai < 2; ++ai)
#pragma unroll
                for (int m = 0; m < MT; ++m) xr[ai][m] = *(const GAS u32x4*)((const GAS bf16_t*)xw + ((unsigned)(rg0 + ai * RH + m * 16) * 1024u + (unsigned)cg));
#pragma unroll
            for (int ai = 0; ai < 2; ++ai)
#pragma unroll
                for (int m = 0; m < MT; ++m) {
                    if (!uni) { const float* gp = gatebase + cond_of_row(rg0 + ai * RH + m * 16) * 6144 + cg; g0 = *(const f32x4*)gp; g1 = *(const f32x4*)(gp + 4); }
                    const u32x4 r = xr[ai][m];
                    const f32x4 x0 = (f32x4){bf2f(r.x & 0xffffu), bf2f(r.x >> 16), bf2f(r.y & 0xffffu), bf2f(r.y >> 16)}, x1 = (f32x4){bf2f(r.z & 0xffffu), bf2f(r.z >> 16), bf2f(r.w & 0xffffu), bf2f(r.w >> 16)};
                    acc[ai][bj][m][0] = x0 * ALPHA + g0 * acc[ai][bj][m][0]; acc[ai][bj][m][1] = x1 * ALPHA + g1 * acc[ai][bj][m][1];
                }
            asm volatile("" ::: "memory");
        }
        LAS f32x2* P = (LAS f32x2*)lds;
        LAS f32x2* S = (LAS f32x2*)(lds + 8192);
#pragma unroll
        for (int ai = 0; ai < 2; ++ai)
#pragma unroll
            for (int m = 0; m < MT; ++m) {
                float s = 0.f;
#pragma unroll
                for (int bj = 0; bj < 2; ++bj)
#pragma unroll
                    for (int n = 0; n < 2; ++n) { const f32x4 x = acc[ai][bj][m][n]; s += (x[0] + x[1]) + (x[2] + x[3]); }
                s += lane_xor(s, lane, 16); s += lane_xor(s, lane, 32);
                const float mw = s * (1.0f / 64.0f); float q = 0.f;
#pragma unroll
                for (int bj = 0; bj < 2; ++bj)
#pragma unroll
                    for (int n = 0; n < 2; ++n) { const f32x4 d = acc[ai][bj][m][n] - mw; q += (d[0] * d[0] + d[1] * d[1]) + (d[2] * d[2] + d[3] * d[3]); }
                q += lane_xor(q, lane, 16); q += lane_xor(q, lane, 32);
                if (fq == 0) P[(ai * RH + wr * RW + m * 16 + fr) * 4 + wc] = (f32x2){mw, q};
            }
        asm volatile("s_waitcnt lgkmcnt(0)" ::: "memory"); __builtin_amdgcn_s_barrier(); asm volatile("" ::: "memory");
        const int row = wid * 32 + (lane & 31);
        const bool pub = wid * 32 < RT;
        if (pub && lane < 32) {
            const f32x2 a = P[row * 4 + 0], b = P[row * 4 + 1], c = P[row * 4 + 2], d = P[row * 4 + 3];
            const float mt = (a.x + b.x + c.x + d.x) * 0.25f;
            const float da = a.x - mt, db = b.x - mt, dc = c.x - mt, dd = d.x - mt;
            const float m2 = (a.y + b.y) + (c.y + d.y) + 64.0f * ((da * da + db * db) + (dc * dc + dd * dd));
            unsigned long long* slot = xbuf + ((size_t)(u.pm * RT + row) * 4 + u.pn);
            __hip_atomic_store(slot, ((unsigned long long)__float_as_uint(m2) << 32) | __float_as_uint(mt), __ATOMIC_RELAXED, __HIP_MEMORY_SCOPE_AGENT);
        }
        asm volatile("s_waitcnt vmcnt(0)" ::: "memory");
        if (pub && lane == 0) __hip_atomic_fetch_add(cnt + 64 * u.pm, 1u, __ATOMIC_RELAXED, __HIP_MEMORY_SCOPE_AGENT);
        if (wid == 0) {
            unsigned sp = 0;
            while ((unsigned)__builtin_amdgcn_readfirstlane(__hip_atomic_load(cnt + 64 * u.pm, __ATOMIC_RELAXED, __HIP_MEMORY_SCOPE_AGENT)) < (unsigned)(RT / 32 * 4)) { __builtin_amdgcn_s_sleep(1); if (++sp > (1u << 22)) break; }
            __builtin_amdgcn_fence(__ATOMIC_ACQUIRE, "agent");
        }
        asm volatile("s_waitcnt vmcnt(0) lgkmcnt(0)" ::: "memory"); __builtin_amdgcn_s_barrier(); asm volatile("" ::: "memory");
        if (pub && lane < 32) {
            const unsigned long long* slot = xbuf + (size_t)(u.pm * RT + row) * 4; float mt[4], m2[4]; float ms = 0.f;
#pragma unroll
            for (int t = 0; t < 4; ++t) { const unsigned long long w = __hip_atomic_load(slot + t, __ATOMIC_RELAXED, __HIP_MEMORY_SCOPE_AGENT); mt[t] = __uint_as_float((unsigned)w); m2[t] = __uint_as_float((unsigned)(w >> 32)); ms += mt[t]; }
            const float mean = ms * 0.25f; float q = 0.f;
#pragma unroll
            for (int t = 0; t < 4; ++t) { const float dm = mt[t] - mean; q += m2[t] + 256.0f * dm * dm; }
            S[row] = (f32x2){mean, __builtin_amdgcn_rsqf(q * (1.0f / 1024.0f) + LN_EPS)};
        }
        asm volatile("s_waitcnt lgkmcnt(0)" ::: "memory"); __builtin_amdgcn_s_barrier(); asm volatile("" ::: "memory");
        int rgs = rg0; asm volatile("" : "+v"(rgs));
#pragma unroll
        for (int bj = 0; bj < 2; ++bj) {
            const int cg = colg0 + bj * HALF;
            const f32x4 ga = *(const f32x4*)(lng + cg), gb = *(const f32x4*)(lng + cg + 4), ba = *(const f32x4*)(lnb + cg), bb = *(const f32x4*)(lnb + cg + 4);
            f32x4 sha = (f32x4){0.f, 0.f, 0.f, 0.f}, shb = sha, sca = sha, scb = sha;
            if (modn) { const float* mr = modn + cond0 * 6144 + cg; sha = *(const f32x4*)mr; shb = *(const f32x4*)(mr + 4); sca = *(const f32x4*)(mr + 1024) + 1.0f; scb = *(const f32x4*)(mr + 1028) + 1.0f; }
#pragma unroll
            for (int ai = 0; ai < 2; ++ai)
#pragma unroll
                for (int m = 0; m < MT; ++m) { const int rl = ai * RH + m * 16; const f32x2 sr = S[rl + wr * RW + fr];
                    const f32x4 y0 = (acc[ai][bj][m][0] - sr.x) * sr.y * ga + ba, y1 = (acc[ai][bj][m][1] - sr.x) * sr.y * gb + bb;
                    const unsigned off = (unsigned)(rgs + rl) * 1024u + (unsigned)cg;
                    if (!modn) { *(GAS f32x4*)((GAS float*)outf + off) = y0; *(GAS f32x4*)((GAS float*)outf + off + 4) = y1; }
                    else {
                        if (!uni) { const float* mr = modn + cond_of_row(rgs + rl) * 6144 + cg; sha = *(const f32x4*)mr; shb = *(const f32x4*)(mr + 4); sca = *(const f32x4*)(mr + 1024) + 1.0f; scb = *(const f32x4*)(mr + 1028) + 1.0f; }
                        u32x4 xo; xo.x = cvt_pk_bf16(y0[0], y0[1]); xo.y = cvt_pk_bf16(y0[2], y0[3]); xo.z = cvt_pk_bf16(y1[0], y1[1]); xo.w = cvt_pk_bf16(y1[2], y1[3]);
                        *(GAS u32x4*)((GAS bf16_t*)xw + off) = xo;
                        const f32x4 h0 = y0 * sca + sha, h1 = y1 * scb + shb;
                        u32x4 ho; ho.x = cvt_pk_bf16(h0[0], h0[1]); ho.y = cvt_pk_bf16(h0[2], h0[3]); ho.z = cvt_pk_bf16(h1[0], h1[1]); ho.w = cvt_pk_bf16(h1[2], h1[3]);
                        *(GAS u32x4*)((GAS bf16_t*)hb + off) = ho; } }
            asm volatile("" ::: "memory");
        }
    }
};

template <int MT, bool ALIGN_EPI, class Epi, class Sched>
__device__ __forceinline__ void gemm_phase(const int wv, LAS unsigned char* lds, const int lda, const int ldb, const int K, const Sched& S, const Epi& E, const int kjt = 1 << 30, const size_t kjb = 0) {
    const int tid = fresh_tid(wv);
    const int wid = __builtin_amdgcn_readfirstlane(tid >> 6), lane = tid & 63, wr = wid >> 2, wc = wid & 3, fr = lane & 15, fq = lane >> 4;
    const int nt = K / BK;
    unsigned voffA[2], voffB[2];
#pragma unroll
    for (int i = 0; i < 2; ++i) { int R, C; stage_rc(tid * 16 + i * 8192, R, C); const int Rb = Epi::PERM ? ((R & ~31) + perm32(R & 31)) : R;
        const int Ra = (MT == 3 && R >= 96) ? R - 32 : R;
        voffA[i] = (unsigned)(Ra * lda + C) * 2u; voffB[i] = (unsigned)(Rb * ldb + C) * 2u; }
    const size_t kstep = (size_t)(BK * 2);
    const size_t hstepA = (size_t)(32 * MT) * lda * 2, hstepB = (size_t)HALF * ldb * 2;
    const unsigned ldsw = (unsigned)wid * 1024u;
    const int aoff = lds_byte(wr * (16 * MT) + fr, fq * 8), boff = lds_byte(wc * 32 + fr, fq * 8);
    const bool light = (MT == 3) && (wr == 1);
#define PG8_SA(b, h) (((b) * 2 + (h)) * HTB)
#define PG8_SB(b, h) ((4 + (b) * 2 + (h)) * HTB)
#define PG8_STAGE(bufoff, gbase, voff) do { _Pragma("unroll") for (int _i = 0; _i < 2; ++_i) \
        __builtin_amdgcn_global_load_lds((const unsigned*)((const char*)(gbase) + (voff)[_i]), (LAS unsigned*)(lds + (bufoff) + ldsw + _i * 8192), 16, 0, 0); } while (0)
#define PG8_STAGEA(bufoff, gbase) do { __builtin_amdgcn_global_load_lds((const unsigned*)((const char*)(gbase) + voffA[0]), (LAS unsigned*)(lds + (bufoff) + ldsw), 16, 0, 0); \
        if (!light) __builtin_amdgcn_global_load_lds((const unsigned*)((const char*)(gbase) + voffA[1]), (LAS unsigned*)(lds + (bufoff) + ldsw + 8192), 16, 0, 0); } while (0)
#define PG8_WAIT_VL(nfull, nlight) do { if (light) PG8_WAIT_V(nlight); else PG8_WAIT_V(nfull); } while (0)
#define PG8_LDA(dst, b, h) do { _Pragma("unroll") for (int m = 0; m < MT; ++m) _Pragma("unroll") for (int k = 0; k < 2; ++k) dst[m][k] = *(const LAS bf16x8*)(lds + PG8_SA(b, h) + aoff + m * 2048 + k * 1024); } while (0)
#define PG8_LDB(dst, b, h) do { _Pragma("unroll") for (int n = 0; n < 2; ++n) _Pragma("unroll") for (int k = 0; k < 2; ++k) dst[n][k] = *(const LAS bf16x8*)(lds + PG8_SB(b, h) + boff + n * 2048 + k * 1024); } while (0)
#define PG8_MMA(ai, bj, At, Bt) do { __builtin_amdgcn_s_setprio(1); _Pragma("unroll") for (int m = 0; m < MT; ++m) _Pragma("unroll") for (int n = 0; n < 2; ++n) _Pragma("unroll") for (int k = 0; k < 2; ++k) \
        acc[ai][bj][m][n] = __builtin_amdgcn_mfma_f32_16x16x32_bf16(Bt[n][k], At[m][k], acc[ai][bj][m][n], 0, 0, 0); __builtin_amdgcn_s_setprio(0); } while (0)
#define PG8_WAIT_V(n) asm volatile("s_waitcnt vmcnt(" #n ")" ::: "memory")
#define PG8_WAIT_L(n) asm volatile("s_waitcnt lgkmcnt(" #n ")" ::: "memory")
#define PG8_WAIT_LA do { if constexpr (MT == 4) PG8_WAIT_L(8); else PG8_WAIT_L(6); } while (0)
#define PG8_BAR __builtin_amdgcn_s_barrier()
#define PG8_SCHED __builtin_amdgcn_sched_barrier(0)
    int ui = 0;
    const char* cA; const char* cB;
    { Unit u0; if (!S.next(0, u0)) return; cA = u0.a; cB = u0.b; }
    f32x4 acc[2][2][MT][2];
#pragma unroll
    for (int a = 0; a < 2; ++a)
#pragma unroll
        for (int b = 0; b < 2; ++b)
#pragma unroll
            for (int m = 0; m < MT; ++m)
#pragma unroll
                for (int n = 0; n < 2; ++n) acc[a][b][m][n] = (f32x4){0.f, 0.f, 0.f, 0.f};
    bf16x8 At[MT][2], B0[2][2], B1[2][2];
    PG8_STAGE(PG8_SB(0, 0), cB, voffB); PG8_STAGE(PG8_SB(0, 1), cB + hstepB, voffB); PG8_STAGEA(PG8_SA(0, 0), cA); PG8_STAGEA(PG8_SA(0, 1), cA + hstepA);
    if (wr == 1) PG8_BAR;
    PG8_WAIT_VL(2, 1); PG8_BAR;
    PG8_STAGE(PG8_SB(1, 0), cB + kstep, voffB); PG8_STAGEA(PG8_SA(1, 0), cA + kstep); PG8_STAGE(PG8_SB(1, 1), cB + hstepB + kstep, voffB);
    PG8_WAIT_VL(6, 5); PG8_BAR;
    for (;;) {
        const char* nA = cA; const char* nB = cB; bool has_next;
        { Unit un; has_next = S.next(ui + 1, un); if (has_next) { nA = un.a; nB = un.b; } }
        for (int t = 0; t < nt; t += 2) {
            const bool last = (t == nt - 2);
            const char* a1 = cA + (size_t)(t + 1) * kstep;
            const char* a2 = last ? nA : cA + (size_t)(t + 2) * kstep; const char* b2 = last ? nB : cB + (size_t)(t + 2) * kstep + (t + 2 >= kjt ? kjb : (size_t)0);
            const char* a3 = a2 + kstep; const char* b3 = b2 + kstep;
            PG8_LDB(B0, 0, 0); PG8_LDB(B1, 0, 1); PG8_SCHED; PG8_LDA(At, 0, 0); PG8_STAGEA(PG8_SA(1, 1), a1 + hstepA);
            PG8_WAIT_VL(8, 6); PG8_WAIT_L(0); PG8_BAR; PG8_MMA(0, 0, At, B0); PG8_MMA(0, 1, At, B1); PG8_BAR; PG8_SCHED;
            PG8_LDA(At, 0, 1); PG8_STAGE(PG8_SB(0, 0), b2, voffB); PG8_STAGE(PG8_SB(0, 1), b2 + hstepB, voffB); PG8_STAGEA(PG8_SA(0, 0), a2);
            PG8_WAIT_VL(8, 6); PG8_WAIT_L(0); PG8_BAR; PG8_MMA(1, 0, At, B0); PG8_MMA(1, 1, At, B1); PG8_BAR; PG8_SCHED;
            PG8_LDB(B0, 1, 0); PG8_LDB(B1, 1, 1); PG8_SCHED; PG8_LDA(At, 1, 0); PG8_STAGEA(PG8_SA(0, 1), a2 + hstepA);
            PG8_WAIT_VL(8, 6); PG8_WAIT_L(0); PG8_BAR; PG8_MMA(0, 0, At, B0); PG8_MMA(0, 1, At, B1); PG8_BAR; PG8_SCHED;
            PG8_LDA(At, 1, 1); PG8_STAGE(PG8_SB(1, 0), b3, voffB); PG8_STAGE(PG8_SB(1, 1), b3 + hstepB, voffB); PG8_STAGEA(PG8_SA(1, 0), a3);
            PG8_WAIT_VL(8, 6); PG8_WAIT_L(0); PG8_BAR; PG8_MMA(1, 0, At, B0); PG8_MMA(1, 1, At, B1); PG8_BAR; PG8_SCHED;
        }
        if constexpr (ALIGN_EPI) { if (wr == 0) PG8_BAR; }
        if constexpr (!Epi::AFTER_DRAIN) { Unit uc; (void)S.next(ui, uc); E.template operator()<MT>(acc, uc, wv); }
        if (!has_next) break;
#pragma unroll
        for (int a = 0; a < 2; ++a)
#pragma unroll
            for (int b = 0; b < 2; ++b)
#pragma unroll
                for (int m = 0; m < MT; ++m)
#pragma unroll
                    for (int n = 0; n < 2; ++n) acc[a][b][m][n] = (f32x4){0.f, 0.f, 0.f, 0.f};
        cA = nA; cB = nB; ++ui;
        if constexpr (ALIGN_EPI) { if (wr == 1) PG8_BAR; }
    }
    PG8_WAIT_V(0);
    if constexpr (!ALIGN_EPI) { if (wr == 0) PG8_BAR; }
    PG8_BAR;
    if constexpr (Epi::AFTER_DRAIN) { Unit uc; (void)S.next(ui, uc); E.template fused<MT>(acc, uc, wv, lds); }
#undef PG8_SA
#undef PG8_SB
#undef PG8_STAGE
#undef PG8_LDA
#undef PG8_STAGEA
#undef PG8_WAIT_VL
#undef PG8_LDB
#undef PG8_MMA
#undef PG8_WAIT_V
#undef PG8_WAIT_L
#undef PG8_WAIT_LA
#undef PG8_BAR
#undef PG8_SCHED
}

struct SchedDense {
    const bf16_t* A; const bf16_t* Bt; int lda, ldb, nM, nN, G, c, rt;
    bf16_t* O; int ldo;
    __device__ __forceinline__ bool next(int i, Unit& u) const {
        const unsigned nwg = (unsigned)(nM * nN); const unsigned L = (unsigned)i * (unsigned)G + (unsigned)c; if (L >= nwg) return false;
        const unsigned lnN = 31u - (unsigned)__builtin_clz((unsigned)nN);
        const unsigned wgid = (L & 7u) * (nwg >> 3) + (L >> 3);
        const unsigned w = wgid & ((8u << lnN) - 1u);
        const int pm = (int)(((wgid >> (3u + lnN)) << 3) + (w & 7u)), pn = (int)(w >> 3);
        u.a = (const char*)(A + (size_t)pm * rt * lda); u.b = (const char*)(Bt + (size_t)pn * 256 * ldb);
        u.o = O + (size_t)pm * rt * ldo + pn * 256; u.ldc = ldo; u.flag = pn >= 2;
        u.x = nullptr; u.gate = nullptr; u.pm = pm; u.pn = pn; u.cond = 0;
        return true;
    }
};
struct SchedD1 {
    const bf16_t* CS; const bf16_t* CSEO; const bf16_t* H; bf16_t* PQT; int G, c, part;
    __device__ __forceinline__ bool next(int i, Unit& u) const {
        if (c < 0) return false;
        const int idx = i * G + c;
        if (part == 0) { if (idx >= 128) return false; const int sb = idx >> 5, rem = idx & 31, g = rem >> 3, eo = (rem >> 2) & 1, pm = (rem >> 1) & 1, pn = rem & 1;
            u.a = (const char*)(CSEO + eo * 262144 + pm * 131072); u.b = (const char*)(H + (size_t)(TC + sb * 1024 + pn * 256) * 1024 + g * 256);
            u.o = PQT + 16777216 + (size_t)(sb * 4 + g) * 524288 + (eo * 2 + pm) * 512 + pn * 256; u.ldc = 2048; }
        else { if (idx >= 256) return false; const int seq = idx >> 3, rem = idx & 7, g = rem >> 1, pm = rem & 1;
            u.a = (const char*)(CS + pm * 65536); u.b = (const char*)(H + (size_t)(seq * 256) * 1024 + g * 256);
            u.o = PQT + (size_t)(seq * 4 + g) * 131072 + pm * 256; u.ldc = 512; }
        u.flag = 0; u.x = nullptr; u.gate = nullptr; u.pm = 0; u.pn = 0; u.cond = 0;
        return true;
    }
};
struct SchedD2 {
    const bf16_t* AS; const bf16_t* PQT; bf16_t* FM; int G, c, part;
    __device__ __forceinline__ bool next(int i, Unit& u) const {
        const int idx = i * G + c;
        if (part == 0) { if (idx >= 64) return false; const int sb = idx >> 4, g = (idx >> 2) & 3, eo = (idx >> 1) & 1, pm = idx & 1;
            u.a = (const char*)(AS + (size_t)eo * 524288 + (size_t)pm * 262144); u.b = (const char*)(PQT + 16777216 + (size_t)(sb * 4 + g) * 524288 + eo * 1024);
            u.o = FM + (size_t)(TC + sb * 1024 + pm * 512 + eo) * 1024 + g * 256; u.ldc = 2048; }
        else { if (idx >= 128) return false; const int seq = idx >> 2, g = idx & 3;
            u.a = (const char*)AS; u.b = (const char*)(PQT + (size_t)(seq * 4 + g) * 131072);
            u.o = FM + (size_t)(seq * 256) * 1024 + g * 256; u.ldc = 1024; }
        u.flag = 0; u.x = nullptr; u.gate = nullptr; u.pm = 0; u.pn = 0; u.cond = 0;
        return true;
    }
};
}

struct TrTile { const float* src; bf16_t* dst; int N, Kd, k0, n0; };
__device__ __forceinline__ TrTile tr_decode(const Params& p, unsigned char* ws, int id) {
    TrTile r;
    if (id < 1024) { const int b = id >> 9, q = id & 511; r.N = 2048; r.Kd = 1024; r.k0 = (q >> 5) * 64; r.n0 = (q & 31) * 64; r.src = p.in[7] + (size_t)b * 1024 * 2048; r.dst = (bf16_t*)(ws + OFF_WIN) + (size_t)b * 2048 * 1024; }
    else if (id < 1536) { const int q0 = id - 1024, b = q0 >> 8, q = q0 & 255; r.N = 1024; r.Kd = 1024; r.k0 = (q >> 4) * 64; r.n0 = (q & 15) * 64; r.src = p.in[19] + (size_t)b * 1048576; r.dst = (bf16_t*)(ws + OFF_WOAB) + (size_t)b * 1048576; }
    else if (id < 2048) { const int q0 = id - 1536, b = q0 >> 8, q = q0 & 255; r.N = 1024; r.Kd = 1024; r.k0 = (q >> 4) * 64; r.n0 = (q & 15) * 64; r.src = p.in[20] + (size_t)b * 1048576; r.dst = (bf16_t*)(ws + OFF_WOC) + (size_t)b * 1048576; }
    else if (id < 6144) { const int q0 = id - 2048, b = q0 >> 10, q = q0 & 1023; r.N = 4096; r.Kd = 1024; r.k0 = (q >> 6) * 64; r.n0 = (q & 63) * 64; r.src = p.in[21] + (size_t)b * 4194304; r.dst = (bf16_t*)(ws + OFF_W1) + (size_t)b * 4194304; }
    else { const int q0 = id - 6144, b = q0 >> 10, q = q0 & 1023; r.N = 1024; r.Kd = 4096; r.k0 = (q >> 4) * 64; r.n0 = (q & 15) * 64; r.src = p.in[22] + (size_t)b * 4194304; r.dst = (bf16_t*)(ws + OFF_W2) + (size_t)b * 4194304; }
    return r;
}
__device__ __forceinline__ void transpose_batch(const Params& p, unsigned char* ws, int id0, float* tl) {
    const int t = threadIdx.x;
    f32x4 v[4][2];
#pragma unroll
    for (int b = 0; b < 4; ++b) { const TrTile tt = tr_decode(p, ws, id0 + b);
#pragma unroll
        for (int i = 0; i < 2; ++i) { const int idx = t + i * 512, r = idx >> 4, c4 = (idx & 15) * 4; v[b][i] = *(const f32x4*)(tt.src + (size_t)(tt.k0 + r) * tt.N + tt.n0 + c4); } }
#pragma unroll
    for (int b = 0; b < 4; ++b)
#pragma unroll
        for (int i = 0; i < 2; ++i) { const int idx = t + i * 512, r = idx >> 4, c4 = (idx & 15) * 4; float* d = tl + b * 4160 + r * 65 + c4; d[0] = v[b][i][0]; d[1] = v[b][i][1]; d[2] = v[b][i][2]; d[3] = v[b][i][3]; }
    __syncthreads();
    const int n = t >> 3, k8 = (t & 7) * 8;
#pragma unroll
    for (int b = 0; b < 4; ++b) { const TrTile tt = tr_decode(p, ws, id0 + b);
        float e[8];
#pragma unroll
        for (int i = 0; i < 8; ++i) e[i] = tl[b * 4160 + (k8 + i) * 65 + n];
        u32x4 w; w.x = cvt_pk_bf16(e[0], e[1]); w.y = cvt_pk_bf16(e[2], e[3]); w.z = cvt_pk_bf16(e[4], e[5]); w.w = cvt_pk_bf16(e[6], e[7]);
        *(u32x4*)(tt.dst + (size_t)(tt.n0 + n) * tt.Kd + tt.k0 + k8) = w; }
    __syncthreads();
}

__device__ __forceinline__ void phase0(const Params& p, float* lds) {
    const int t = threadIdx.x;
    unsigned char* ws = p.ws;
    if (t < 25) ((const float**)(ws + OFF_TAB))[t] = p.in[t];
    for (int u = blockIdx.x; u < 192; u += gridDim.x) {
        float* S = lds;
        float* red = lds + 5120;
        for (int i = t; i < 5120; i += NTHR) { const int ci = i >> 10, k = i & 1023; const float cv = ci == 0 ? p.in[4][k] : p.in[3][(ci - 1) * 1024 + k]; S[i] = cv * sigmoidf_(cv); }
        __syncthreads();
        const int col0 = u * 128, l = col0 / 6144, n0 = col0 % 6144, cq = t & 31, ks = t >> 5;
        float acc[5][4];
#pragma unroll
        for (int ci = 0; ci < 5; ++ci)
#pragma unroll
            for (int e = 0; e < 4; ++e) acc[ci][e] = 0.f;
        const float* wp = p.in[5] + ((size_t)l * 1024 + ks * 64) * 6144 + n0 + cq * 4;
#pragma unroll 4
        for (int kk = 0; kk < 64; ++kk) {
            const f32x4 w = __builtin_nontemporal_load((const f32x4*)(wp + (size_t)kk * 6144));
#pragma unroll
            for (int ci = 0; ci < 5; ++ci) { const float s = S[ci * 1024 + ks * 64 + kk];
#pragma unroll
                for (int e = 0; e < 4; ++e) acc[ci][e] += s * w[e]; }
        }
#pragma unroll
        for (int ci = 0; ci < 5; ++ci)
#pragma unroll
            for (int e = 0; e < 4; ++e) red[(ks * 5 + ci) * 128 + cq * 4 + e] = acc[ci][e];
        __syncthreads();
        float* mod = (float*)(ws + OFF_MOD);
        for (int o = t; o < 640; o += NTHR) { const int ci = o >> 7, cn = o & 127; float s = 0.f;
#pragma unroll
            for (int k2 = 0; k2 < 16; ++k2) s += red[(k2 * 5 + ci) * 128 + cn];
            mod[(l * 5 + ci) * 6144 + n0 + cn] = s + p.in[6][l * 6144 + n0 + cn]; }
        __syncthreads();
    }
    for (int id0 = blockIdx.x * 4; id0 < 10240; id0 += gridDim.x * 4) transpose_batch(p, ws, id0, lds);
    {
        const int gtid = blockIdx.x * NTHR + t, gsz = gridDim.x * NTHR;
        float* pp = (float*)(ws + OFF_PP);
        for (int i = gtid; i < PP_END; i += gsz) { float v;
            if (i < PP_CONVB) v = p.in[8][i]; else if (i < PP_BA) v = p.in[9][i - PP_CONVB]; else if (i < PP_BX) v = p.in[11][i - PP_BA]; else if (i < PP_SP) v = p.in[13][i - PP_BX];
            else if (i < PP_SGLG) { const float lam = p.in[14][i - PP_SP]; v = flog(1.0f + fexp(-lam)); }
            else if (i < PP_SGLB) v = p.in[15][i - PP_SGLG]; else if (i < PP_SGBS) v = p.in[16][i - PP_SGLB]; else if (i < PP_LNG) v = p.in[18][i - PP_SGBS];
            else if (i < PP_LNB) v = p.in[23][i - PP_LNG]; else if (i < PP_STATE) v = p.in[24][i - PP_LNB]; else v = p.in[2][i - PP_STATE];
            pp[i] = v; }
        bf16_t* pwt = (bf16_t*)(ws + OFF_PWT);
        for (int i = gtid; i < 262144; i += gsz) { const int ii = i & 63, oo = (i >> 6) & 63, m = (i >> 12) & 3, hd = (i >> 14) & 7, j = i >> 17;
            const float* s = ((m & 1) ? p.in[12] : p.in[10]) + (size_t)(((j * 2 + (m >> 1)) * 8 + hd) * 4096);
            pwt[i] = f2bf(s[ii * 64 + oo]); }
        bf16_t* psg = (bf16_t*)(ws + OFF_PSGW);
        for (int i = gtid; i < 131072; i += gsz) psg[i] = f2bf(p.in[17][i]);
        bf16_t* cs = (bf16_t*)(ws + OFF_CS256); bf16_t* a256 = (bf16_t*)(ws + OFF_AS256); bf16_t* a1024 = (bf16_t*)(ws + OFF_AS1024);
        for (int idx = gtid; idx < 131072; idx += gsz) {
            { const int j = idx >> 8, k = idx & 255, m = ((j & 255) * k) & 255; const float ang = (float)m * (1.0f / 128.0f);
              cs[idx] = f2bf((j < 256 ? __builtin_amdgcn_cosf(ang * 0.5f) : __builtin_amdgcn_sinf(ang * 0.5f)) * 0.0625f); }
            { const int s = idx >> 9, kk = idx & 511, m = (s * (kk & 255)) & 255; const float ang = (float)m * (1.0f / 128.0f);
              a256[idx] = f2bf((kk < 256 ? __builtin_amdgcn_cosf(ang * 0.5f) : -__builtin_amdgcn_sinf(ang * 0.5f)) * 0.0625f); }
        }
        for (int idx = gtid; idx < 1048576; idx += gsz) { const int eo = idx >> 19, m = (idx >> 10) & 511, kk = idx & 1023, mm = ((2 * m + eo) * (kk & 511)) & 1023; const float ang = (float)mm * (1.0f / 1024.0f);
            a1024[idx] = f2bf((kk < 512 ? __builtin_amdgcn_cosf(ang) : -__builtin_amdgcn_sinf(ang)) * 0.03125f); }
        bf16_t* cseo = a1024 + 1048576;
        for (int idx = gtid; idx < 524288; idx += gsz) { const int eo = idx >> 18, j = (idx >> 9) & 511, kk = idx & 511, mm = ((j & 255) * (kk & 255)) & 255; const float ang = (float)mm * (1.0f / 256.0f);
            const float v = (j < 256 ? __builtin_amdgcn_cosf(ang) : __builtin_amdgcn_sinf(ang)) * 0.0625f; cseo[idx] = f2bf((kk >= 256 && eo) ? -v : v); }
    }
}

__device__ __forceinline__ void phase_init_rows(const Params& p) {
    const int lane = threadIdx.x & 63, wid = threadIdx.x >> 6;
    const float* mod = (const float*)(p.ws + OFF_MOD);
    const __amdgpu_buffer_rsrc_t rsx = __builtin_amdgcn_make_buffer_rsrc((void*)(p.ws + OFF_XW), 0, 0x7fffffff, 0x00020000), rsh = __builtin_amdgcn_make_buffer_rsrc((void*)(p.ws + OFF_H), 0, 0x7fffffff, 0x00020000);
    for (int row = blockIdx.x * 8 + wid; row < T; row += gridDim.x * 8) {
        const int cond = row < TC ? 0 : 1 + ((row - TC) >> 10);
        const float* src = row < TC ? p.in[0] + (size_t)row * 1024 : p.in[1] + (size_t)(row - TC) * 1024;
        const float* mc = mod + cond * 6144;
#pragma unroll
        for (int i = 0; i < 2; ++i) { const int col = i * 512 + lane * 8;
            const f32x4 v0 = __builtin_nontemporal_load((const f32x4*)(src + col)), v1 = __builtin_nontemporal_load((const f32x4*)(src + col + 4));
            u32x4 xo; xo.x = cvt_pk_bf16(v0[0], v0[1]); xo.y = cvt_pk_bf16(v0[2], v0[3]); xo.z = cvt_pk_bf16(v1[0], v1[1]); xo.w = cvt_pk_bf16(v1[2], v1[3]);
            __builtin_amdgcn_raw_buffer_store_b128(xo, rsx, (unsigned)((row * 1024 + col) * 2), 0, 18);
            const f32x4 sh0 = *(const f32x4*)(mc + col), sh1 = *(const f32x4*)(mc + col + 4), sc0 = *(const f32x4*)(mc + 1024 + col), sc1 = *(const f32x4*)(mc + 1024 + col + 4);
            const f32x4 h0 = v0 * (1.0f + sc0) + sh0, h1 = v1 * (1.0f + sc1) + sh1;
            u32x4 ho; ho.x = cvt_pk_bf16(h0[0], h0[1]); ho.y = cvt_pk_bf16(h0[2], h0[3]); ho.z = cvt_pk_bf16(h1[0], h1[1]); ho.w = cvt_pk_bf16(h1[2], h1[3]);
            __builtin_amdgcn_raw_buffer_store_b128(ho, rsh, (unsigned)((row * 1024 + col) * 2), 0, 18); }
    }
}

__device__ __forceinline__ void lru_unit(const int wv, const Params& p, const int j, const int ct, const int hd, const bool stage_w, unsigned char* lds) {
    const int t = fresh_tid(wv);
    const int w = t >> 6, lane = t & 63, fr = lane & 15, fq = lane >> 4;
    unsigned char* ws = p.ws; asm volatile("" : "+s"(ws));
    const GAS bf16_t* proj = (const GAS bf16_t*)(ws + OFF_PROJ);
    const GAS float* pp = (const GAS float*)(ws + OFF_PP);
    bf16_t* XA = (bf16_t*)lds;
    bf16_t* XC = (bf16_t*)(lds + 37440);
    bf16_t* WT = (bf16_t*)(lds + 74304);
    f32x2* AGG = (f32x2*)(lds + 111168);
    float* PRM = (float*)(lds + 128064);
    const bool is_ctx = ct < 32;
    const int row0 = ct * 256;
    const int seqlo = is_ctx ? row0 : TC + ((ct - 32) >> 2) * 1024, seqhi = seqlo + (is_ctx ? 256 : 1024);
    if (stage_w) for (int i = t; i < 704; i += NTHR) { const int r = i >> 6, c = i & 63, ch = hd * 64 + c; int off;
        if (r < 4) off = PP_CONVW + (j * 4 + r) * 512 + ch; else if (r == 4) off = PP_CONVB + j * 512 + ch;
        else { const int k = r - 5, dir = k & 1, which = k >> 1; off = (which == 0 ? PP_BA : which == 1 ? PP_BX : PP_SP) + (j * 2 + dir) * 512 + ch; }
        PRM[i] = pp[off]; }
    for (int idx = t; idx < 2080; idx += NTHR) { const int rr = idx >> 3, pc = idx & 7, grow = row0 + rr - 2;
        u32x4 v = (u32x4){0u, 0u, 0u, 0u};
        if (grow >= seqlo && grow < seqhi) v = *(const GAS u32x4*)(proj + (size_t)grow * 2048 + hd * 64 + pc * 8);
        *(u32x4*)((unsigned char*)XA + rr * 144 + pc * 16) = v; }
    if (stage_w) { const GAS bf16_t* pwt = (const GAS bf16_t*)(ws + OFF_PWT) + (size_t)(j * 8 + hd) * 16384;
#pragma unroll
      for (int i = 0; i < 4; ++i) { const int pc = t + NTHR * i, row = pc >> 3, c8 = pc & 7;
          *(u32x4*)((unsigned char*)WT + row * 144 + c8 * 16) = *(const GAS u32x4*)(pwt + row * 64 + c8 * 8); } }
    __syncthreads();
#pragma unroll 1
    for (int nt = 0; nt < 4; ++nt) { const int cl = nt * 16 + fr;
        const float c0 = PRM[cl], c1 = PRM[64 + cl], c2 = PRM[128 + cl], c3 = PRM[192 + cl], cb = PRM[256 + cl];
#pragma unroll
        for (int mt = 0; mt < 2; ++mt) { const int pb = 32 * w + 16 * mt + 4 * fq; float xv[7];
#pragma unroll
            for (int r = 0; r < 7; ++r) xv[r] = bf2f(XA[(pb + r) * 72 + cl]);
#pragma unroll
            for (int jj = 0; jj < 4; ++jj) XC[(pb + jj) * 72 + cl] = f2bf(cb + c0 * xv[jj] + c1 * xv[jj + 1] + c2 * xv[jj + 2] + c3 * xv[jj + 3]); } }
    __syncthreads();
    bf16x8 af[2][2];
#pragma unroll
    for (int mt = 0; mt < 2; ++mt)
#pragma unroll
        for (int ks = 0; ks < 2; ++ks) af[mt][ks] = *(const bf16x8*)((const unsigned char*)XC + (32 * w + 16 * mt + fr) * 144 + (ks * 32 + fq * 8) * 2);
    GAS bf16_t* yab = (GAS bf16_t*)(ws + OFF_YAB);
    GAS float* outst = (GAS float*)p.out + (size_t)T * 1024;
    bf16_t* GAT = (bf16_t*)(lds + 37440);
    bf16_t* OUT = (bf16_t*)(lds + 37440 + 16384);
    __syncthreads();
#pragma unroll 1
    for (int nh = 0; nh < 2; ++nh) {
        float xc[2][2][4], hsum[2][2][4], pfv[2][2][4], pbv[2][2][4];
#pragma unroll
        for (int i = 0; i < 2; ++i) { const int pc = t + NTHR * i, row = pc >> 2, c16 = pc & 3;
            *(u32x4*)(GAT + row * 32 + c16 * 8) = *(const GAS u32x4*)(proj + (size_t)(row0 + row) * 2048 + 512 + hd * 64 + nh * 32 + c16 * 8); }
#pragma unroll
        for (int n2 = 0; n2 < 2; ++n2) { const int cl = (nh * 2 + n2) * 16 + fr;
            const float c0 = PRM[cl], c1 = PRM[64 + cl], c2 = PRM[128 + cl], c3 = PRM[192 + cl], cb = PRM[256 + cl];
#pragma unroll
            for (int mt = 0; mt < 2; ++mt) { const int pb = 32 * w + 16 * mt + 4 * fq; float xv[7];
#pragma unroll
                for (int r = 0; r < 7; ++r) xv[r] = bf2f(XA[(pb + r) * 72 + cl]);
#pragma unroll
                for (int jj = 0; jj < 4; ++jj) { xc[mt][n2][jj] = cb + c0 * xv[jj] + c1 * xv[jj + 1] + c2 * xv[jj + 2] + c3 * xv[jj + 3]; hsum[mt][n2][jj] = 0.f;
                    pfv[mt][n2][jj] = 0.f; pbv[mt][n2][jj] = 0.f; } } }
#pragma unroll 1
        for (int dir = 0; dir < 2; ++dir) {
            const bool rev = dir != 0;
            float av[2][2][4], uv[2][2][4];
#pragma unroll
            for (int n2 = 0; n2 < 2; ++n2) { const int cl = (nh * 2 + n2) * 16 + fr;
                const float ba = PRM[(5 + dir) * 64 + cl], bx = PRM[(7 + dir) * 64 + cl], sp = PRM[(9 + dir) * 64 + cl];
                bf16x8 wa[2], wx[2];
#pragma unroll
                for (int ks = 0; ks < 2; ++ks) { wa[ks] = *(const bf16x8*)((const unsigned char*)WT + (((dir * 2 + 0) * 64 + cl) * 72 + ks * 32 + fq * 8) * 2);
                    wx[ks] = *(const bf16x8*)((const unsigned char*)WT + (((dir * 2 + 1) * 64 + cl) * 72 + ks * 32 + fq * 8) * 2); }
#pragma unroll
                for (int mt = 0; mt < 2; ++mt) { f32x4 ar = (f32x4){0.f, 0.f, 0.f, 0.f}, ai = (f32x4){0.f, 0.f, 0.f, 0.f};
#pragma unroll
                    for (int ks = 0; ks < 2; ++ks) { ar = __builtin_amdgcn_mfma_f32_16x16x32_bf16(af[mt][ks], wa[ks], ar, 0, 0, 0); ai = __builtin_amdgcn_mfma_f32_16x16x32_bf16(af[mt][ks], wx[ks], ai, 0, 0, 0); }
#pragma unroll
                    for (int q = 0; q < 4; ++q) { const float arq = rev ? ar[3 - q] : ar[q], aiq = rev ? ai[3 - q] : ai[q], xq = rev ? xc[mt][n2][3 - q] : xc[mt][n2][q];
                        const float r = sigmoidf_(arq + ba), ig = sigmoidf_(aiq + bx);
                        const float la = -8.0f * r * sp; const float a_ = fexp(la); av[mt][n2][q] = a_; uv[mt][n2][q] = __builtin_amdgcn_sqrtf(1.0f - a_ * a_) * (ig * xq); } } }
#pragma unroll
            for (int mt = 0; mt < 2; ++mt)
#pragma unroll
                for (int n2 = 0; n2 < 2; ++n2) { float A = av[mt][n2][0], U = uv[mt][n2][0];
#pragma unroll
                    for (int q = 1; q < 4; ++q) { U = av[mt][n2][q] * U + uv[mt][n2][q]; A *= av[mt][n2][q]; }
                    AGG[(8 * w + 4 * mt + fq) * 33 + n2 * 16 + fr] = (f32x2){A, U}; }
            __syncthreads();
            {
                const int seg = rev ? 63 - lane : lane;
#pragma unroll
                for (int k = 0; k < 4; ++k) { const int c = w * 4 + k; const f32x2 au = AGG[seg * 33 + c]; float A = au.x, U = au.y;
#pragma unroll
                    for (int d = 1; d < 64; d <<= 1) { const float Ap = __int_as_float(__builtin_amdgcn_ds_bpermute(((lane - d) & 63) << 2, __float_as_int(A))), Up = __int_as_float(__builtin_amdgcn_ds_bpermute(((lane - d) & 63) << 2, __float_as_int(U)));
                        if (lane >= d) { U = A * Up + U; A = A * Ap; } }
                    float Pin = __int_as_float(__builtin_amdgcn_ds_bpermute(((lane - 1) & 63) << 2, __float_as_int(A))), Hin = __int_as_float(__builtin_amdgcn_ds_bpermute(((lane - 1) & 63) << 2, __float_as_int(U)));
                    if (lane == 0) { Pin = 1.f; Hin = 0.f; }
                    AGG[seg * 33 + c] = (f32x2){Pin, Hin};
                    if (lane == 63) { const int chg = hd * 64 + nh * 32 + c;
                        if (is_ctx) outst[((ct * 2 + j) * 2 + dir) * 512 + chg] = U;
                        else { unsigned long long* agg = (unsigned long long*)(ws + OFF_AGG); const int sb = (ct - 32) >> 2, cch = (ct - 32) & 3;
                            __hip_atomic_store(agg + (((sb * 4 + cch) * 2 + dir) * 512) + chg, ((unsigned long long)__float_as_uint(U) << 32) | __float_as_uint(A), __ATOMIC_RELAXED, __HIP_MEMORY_SCOPE_AGENT); } } } }
            __syncthreads();
#pragma unroll
            for (int mt = 0; mt < 2; ++mt)
#pragma unroll
                for (int n2 = 0; n2 < 2; ++n2) { const f32x2 cin = AGG[(8 * w + 4 * mt + fq) * 33 + n2 * 16 + fr]; float P = cin.x, hh = cin.y; float hq[4], pq[4];
#pragma unroll
                    for (int q = 0; q < 4; ++q) { hh = av[mt][n2][q] * hh + uv[mt][n2][q]; P *= av[mt][n2][q]; hq[q] = hh; pq[q] = P; }
#pragma unroll
                    for (int jj = 0; jj < 4; ++jj) { hsum[mt][n2][jj] += rev ? hq[3 - jj] : hq[jj];
                        const float pv = rev ? pq[3 - jj] : pq[jj]; pfv[mt][n2][jj] = rev ? pfv[mt][n2][jj] : pv; pbv[mt][n2][jj] = rev ? pv : pbv[mt][n2][jj]; } }
            __syncthreads();
        }
        float cfv[2], cbv[2]; cfv[0] = cfv[1] = cbv[0] = cbv[1] = 0.f;
        if (!is_ctx) {
            const int sb = (ct - 32) >> 2, cch = (ct - 32) & 3;
            unsigned* lcnt = (unsigned*)(ws + OFF_LCNT) + ((((j * 4 + sb) * 8 + hd) * 2 + nh) * 16);
            asm volatile("s_waitcnt vmcnt(0)" ::: "memory");
            __syncthreads();
            if (t == 0) __hip_atomic_fetch_add(lcnt, 1u, __ATOMIC_RELAXED, __HIP_MEMORY_SCOPE_AGENT);
            if (w == 0) { unsigned sp = 0;
                while ((unsigned)__builtin_amdgcn_readfirstlane(__hip_atomic_load(lcnt, __ATOMIC_RELAXED, __HIP_MEMORY_SCOPE_AGENT)) < 4u) { __builtin_amdgcn_s_sleep(2); if (++sp > (1u << 22)) break; }
                __builtin_amdgcn_fence(__ATOMIC_ACQUIRE, "agent"); }
            asm volatile("s_waitcnt vmcnt(0) lgkmcnt(0)" ::: "memory"); __syncthreads();
            const unsigned long long* agg = (const unsigned long long*)(ws + OFF_AGG);
#pragma unroll
            for (int n2 = 0; n2 < 2; ++n2) { const int ch = hd * 64 + (nh * 2 + n2) * 16 + fr;
                float hf = pp[PP_STATE + ((sb * 2 + j) * 2 + 0) * 512 + ch], hb = pp[PP_STATE + ((sb * 2 + j) * 2 + 1) * 512 + ch];
                unsigned long long af_[4], ab_[4];
#pragma unroll
                for (int cc = 0; cc < 4; ++cc) { af_[cc] = __hip_atomic_load(agg + (((sb * 4 + cc) * 2 + 0) * 512) + ch, __ATOMIC_RELAXED, __HIP_MEMORY_SCOPE_AGENT); ab_[cc] = __hip_atomic_load(agg + (((sb * 4 + cc) * 2 + 1) * 512) + ch, __ATOMIC_RELAXED, __HIP_MEMORY_SCOPE_AGENT); }
#pragma unroll
                for (int cc = 0; cc < 4; ++cc) { const float A = __uint_as_float((unsigned)af_[cc]), U = __uint_as_float((unsigned)(af_[cc] >> 32)); hf = cc < cch ? A * hf + U : hf; }
#pragma unroll
                for (int cc = 3; cc >= 0; --cc) { const float A = __uint_as_float((unsigned)ab_[cc]), U = __uint_as_float((unsigned)(ab_[cc] >> 32)); hb = cc > cch ? A * hb + U : hb; }
                cfv[n2] = hf; cbv[n2] = hb; }
        }
#pragma unroll
        for (int mt = 0; mt < 2; ++mt)
#pragma unroll
            for (int n2 = 0; n2 < 2; ++n2)
#pragma unroll
                for (int jj = 0; jj < 4; ++jj) { const int pos = 32 * w + 16 * mt + 4 * fq + jj, cl2 = n2 * 16 + fr;
                    const float hv = hsum[mt][n2][jj] + pfv[mt][n2][jj] * cfv[n2] + pbv[mt][n2][jj] * cbv[n2];
                    OUT[pos * 32 + cl2] = f2bf(hv * bf2f(GAT[pos * 32 + cl2])); }
        __syncthreads();
#pragma unroll
        for (int i = 0; i < 2; ++i) { const int pc = t + NTHR * i, row = pc >> 2, c16 = pc & 3;
            *(GAS u32x4*)(yab + (size_t)(row0 + row) * 1024 + hd * 64 + nh * 32 + c16 * 8) = *(const u32x4*)(OUT + row * 32 + c16 * 8); }
        __syncthreads();
    }
}

__device__ __forceinline__ void lru_fix_unit(const int wv, const Params& p, const int j, const int lc, const int hd) {
    const int t = fresh_tid(wv); unsigned char* ws = p.ws; asm volatile("" : "+s"(ws));
    const int sb = lc >> 2, c = lc & 3, ch = hd * 64 + (t & 15) * 4, r0 = t >> 4;
    const float* agg = (const float*)(ws + OFF_AGG);
    f32x4 cf, cb;
#pragma unroll
    for (int e = 0; e < 4; ++e) {
        float hf = ((const GAS float*)(ws + OFF_PP))[PP_STATE + ((sb * 2 + j) * 2 + 0) * 512 + ch + e];
        for (int cc = 0; cc < c; ++cc) { const f32x2 au = *(const f32x2*)(agg + ((((sb * 4 + cc) * 2 + 0) * 512) + ch + e) * 2); hf = au.x * hf + au.y; }
        float hb = ((const GAS float*)(ws + OFF_PP))[PP_STATE + ((sb * 2 + j) * 2 + 1) * 512 + ch + e];
        for (int cc = 3; cc > c; --cc) { const f32x2 au = *(const f32x2*)(agg + ((((sb * 4 + cc) * 2 + 1) * 512) + ch + e) * 2); hb = au.x * hb + au.y; }
        cf[e] = hf; cb[e] = hb; }
    const float* S1 = (const float*)(ws + OFF_F1); const float* PF = (const float*)(ws + OFF_F1 + 8388608); const float* PBk = (const float*)(ws + OFF_F1 + 16777216);
    const bf16_t* proj = (const bf16_t*)(ws + OFF_PROJ); bf16_t* yab = (bf16_t*)(ws + OFF_YAB);
#pragma unroll
    for (int i = 0; i < 8; ++i) { const int lrow = lc * 256 + r0 + 32 * i; const size_t o = (size_t)lrow * 512 + ch;
        const f32x4 s1 = *(const f32x4*)(S1 + o), pf = *(const f32x4*)(PF + o), pb = *(const f32x4*)(PBk + o);
        const u32x2 gw = *(const u32x2*)(proj + (size_t)(TC + lrow) * 2048 + 512 + ch);
        const f32x4 hv = s1 + pf * cf + pb * cb;
        u32x2 w; w.x = cvt_pk_bf16(hv[0] * bf2f(gw.x & 0xffffu), hv[1] * bf2f(gw.x >> 16)); w.y = cvt_pk_bf16(hv[2] * bf2f(gw.y & 0xffffu), hv[3] * bf2f(gw.y >> 16));
        *(u32x2*)(yab + (size_t)(TC + lrow) * 1024 + ch) = w; }
}

__device__ __forceinline__ void sgu_unit(const int wv, const Params& p, const int j, const int c, const int g, const bool stage_w, unsigned char* lds) {
    const int t = fresh_tid(wv);
    const int w = t >> 6, lane = t & 63, fr = lane & 15, fq = lane >> 4;
    unsigned char* ws = p.ws; asm volatile("" : "+s"(ws));
    const GAS bf16_t* proj = (const GAS bf16_t*)(ws + OFF_PROJ); GAS bf16_t* yab = (GAS bf16_t*)(ws + OFF_YAB);
    bf16_t* VT = (bf16_t*)lds;
    bf16_t* WS = (bf16_t*)(lds + 34816);
    f32x2* ST = (f32x2*)(lds + 69632);
    float* SP = (float*)(lds + 70656);
    const int row0 = c * 128;
    { const int l16 = t & 15, rsub = t >> 4; float eps = LN_EPS; asm volatile("" : "+s"(eps));
      u32x4 raw[4][4];
#pragma unroll
      for (int ps = 0; ps < 4; ++ps) { const GAS bf16_t* vp = proj + (size_t)(row0 + ps * 32 + rsub) * 2048 + 1536;
#pragma unroll
          for (int i = 0; i < 4; ++i) raw[ps][i] = *(const GAS u32x4*)(vp + (i * 16 + l16) * 8); }
#pragma unroll
      for (int ps = 0; ps < 4; ++ps) { float s = 0.f;
#pragma unroll
          for (int i = 0; i < 4; ++i)
#pragma unroll
              for (int e2 = 0; e2 < 4; ++e2) s += bf2f(raw[ps][i][e2] & 0xffffu) + bf2f(raw[ps][i][e2] >> 16);
          s += lane_xor(s, lane, 1); s += lane_xor(s, lane, 2); s += lane_xor(s, lane, 4); s += lane_xor(s, lane, 8);
          const float mean = s * (1.0f / 512.0f); float q = 0.f;
#pragma unroll
          for (int i = 0; i < 4; ++i)
#pragma unroll
              for (int e2 = 0; e2 < 4; ++e2) { const float a = bf2f(raw[ps][i][e2] & 0xffffu) - mean, b = bf2f(raw[ps][i][e2] >> 16) - mean; q += a * a + b * b; }
          q += lane_xor(q, lane, 1); q += lane_xor(q, lane, 2); q += lane_xor(q, lane, 4); q += lane_xor(q, lane, 8);
          if (l16 == 0) ST[ps * 32 + rsub] = (f32x2){mean, __builtin_amdgcn_rsqf(q * (1.0f / 512.0f) + eps)}; } }
    if (stage_w) { const GAS bf16_t* wsrc = (const GAS bf16_t*)(ws + OFF_PSGW) + (size_t)((j * 4 + g) * 16384);
#pragma unroll
      for (int i = 0; i < 4; ++i) { const int pc = t + NTHR * i, row = pc >> 4, c8 = pc & 15;
          *(u32x4*)((unsigned char*)WS + row * 272 + c8 * 16) = *(const GAS u32x4*)(wsrc + row * 128 + c8 * 8); }
      const GAS float* pp = (const GAS float*)(ws + OFF_PP);
      if (t < 384) { const int r = t >> 7, c = t & 127; SP[t] = pp[(r == 0 ? PP_SGLG + j * 512 + g * 128 : r == 1 ? PP_SGLB + j * 512 + g * 128 : PP_SGBS + (j * 4 + g) * 128) + c]; } }
    __syncthreads();
    { const int q = t >> 2, d0 = (t & 3) * 32; const f32x2 st = ST[q]; const GAS bf16_t* vp = proj + (size_t)(row0 + q) * 2048 + 1536 + g * 128 + d0;
      const float* lg = SP + d0; const float* lb = SP + 128 + d0;
#pragma unroll
      for (int i = 0; i < 4; ++i) { const u32x4 raw = *(const GAS u32x4*)(vp + i * 8);
#pragma unroll
          for (int e = 0; e < 4; ++e) { const int d = i * 8 + e * 2;
              const float a = (bf2f(raw[e] & 0xffffu) - st.x) * st.y * lg[d] + lb[d], b = (bf2f(raw[e] >> 16) - st.x) * st.y * lg[d + 1] + lb[d + 1];
              VT[(d0 + d) * 136 + q] = f2bf(a); VT[(d0 + d + 1) * 136 + q] = f2bf(b); } } }
    __syncthreads();
    bf16x8 yf[4];
#pragma unroll
    for (int ks = 0; ks < 4; ++ks) yf[ks] = *(const bf16x8*)((const unsigned char*)WS + ((16 * w + fr) * 136 + ks * 32 + fq * 8) * 2);
    const int pp = 16 * w + fr, row = row0 + pp;
    const float bsv = SP[256 + pp];
#pragma unroll
    for (int dt = 0; dt < 8; ++dt) { f32x4 acc = (f32x4){0.f, 0.f, 0.f, 0.f};
#pragma unroll
        for (int ks = 0; ks < 4; ++ks) { const bf16x8 xf = *(const bf16x8*)((const unsigned char*)VT + ((16 * dt + fr) * 136 + ks * 32 + fq * 8) * 2);
            acc = __builtin_amdgcn_mfma_f32_16x16x32_bf16(xf, yf[ks], acc, 0, 0, 0); }
        const int d = 16 * dt + 4 * fq;
        const u32x2 gu = *(const GAS u32x2*)(proj + (size_t)row * 2048 + 1024 + g * 128 + d);
        u32x2 o; o.x = cvt_pk_bf16((acc[0] + bsv) * bf2f(gu.x & 0xffffu), (acc[1] + bsv) * bf2f(gu.x >> 16)); o.y = cvt_pk_bf16((acc[2] + bsv) * bf2f(gu.y & 0xffffu), (acc[3] + bsv) * bf2f(gu.y >> 16));
        *(GAS u32x2*)(yab + (size_t)row * 1024 + 512 + g * 128 + d) = o; }
    __syncthreads();
}

#define XB_TMO      128
#define XB_XCNT(j)  (256  + 64 * (j))
#define XB_XSUB(j)  (1280 + 64 * (j))
#define XB_XGEN(j)  (2304 + 64 * (j))
#define XB_TOP      3328
#define XB_TOPGEN   3392
#define XCD_BAR_WORDS 3456
#define XB_SPIN_CAP (1u << 22)
__device__ __forceinline__ unsigned xb_ld(unsigned* p)              { return __hip_atomic_load(p, __ATOMIC_RELAXED, __HIP_MEMORY_SCOPE_AGENT); }
__device__ __forceinline__ unsigned xb_add(unsigned* p, unsigned v) { return __hip_atomic_fetch_add(p, v, __ATOMIC_RELAXED, __HIP_MEMORY_SCOPE_AGENT); }
__device__ __forceinline__ unsigned xb_xcc_id() { return (unsigned)__builtin_amdgcn_s_getreg((3 << 11) | 20) & 0xFu; }
#define XB_SPIN(cond, bar) do { unsigned _sp = 0; while (cond) { __builtin_amdgcn_s_sleep(1); \
    if ((++_sp & 255u) == 0u) { if (xb_ld(&(bar)[XB_TMO])) break; if (_sp > XB_SPIN_CAP) { atomicAdd(&(bar)[XB_TMO], 1u); break; } } } } while (0)
__device__ __forceinline__ void xcd_barrier_complete(unsigned* bar, unsigned x, unsigned& nloc, unsigned& nx) {
    const unsigned G = gridDim.x * gridDim.y * gridDim.z;
    unsigned sum, cnt, mine, sp = 0u;
    for (;;) {
        sum = 0u; cnt = 0u; mine = 0u;
#pragma unroll
        for (unsigned j = 0; j < 16; ++j) { const unsigned c = xb_ld(&bar[XB_XCNT(j)]); sum += c; cnt += (c > 0u) ? 1u : 0u; mine = (j == x) ? c : mine; }
        if (sum == G) break;
        __builtin_amdgcn_s_sleep(1);
        if ((++sp & 255u) == 0u) { if (xb_ld(&bar[XB_TMO])) break; if (sp > XB_SPIN_CAP) { atomicAdd(&bar[XB_TMO], 1u); break; } }
    }
    nloc = mine > 0u ? mine : 1u; nx = cnt > 0u ? cnt : 1u;
}
__device__ __forceinline__ void xcd_barrier(const int wv, unsigned* bar, volatile LAS unsigned* st) {
    asm volatile("s_waitcnt vmcnt(0)" ::: "memory");
    __syncthreads();
    if (fresh_tid(wv) == 0) {
        const unsigned x = xb_xcc_id();
        __builtin_amdgcn_s_waitcnt(0);
        unsigned nloc = st[0], nx = st[1];
        if (nloc == 0u) { xcd_barrier_complete(bar, x, nloc, nx); st[0] = nloc; st[1] = nx; }
        const unsigned old = xb_add(&bar[XB_XSUB(x)], 1u);
        const unsigned gen = old / nloc;
        if (old + 1u == (gen + 1u) * nloc) {
            __builtin_amdgcn_fence(__ATOMIC_RELEASE, "agent");
            asm volatile("s_waitcnt vmcnt(0)" ::: "memory");
            const unsigned og = xb_add(&bar[XB_TOP], 1u);
            const unsigned tg = og / nx;
            if (og + 1u == (tg + 1u) * nx) xb_add(&bar[XB_TOPGEN], 1u);
            else XB_SPIN(xb_ld(&bar[XB_TOPGEN]) == tg, bar);
            __builtin_amdgcn_fence(__ATOMIC_ACQUIRE, "agent");
            xb_add(&bar[XB_XGEN(x)], 1u);
            asm volatile("s_waitcnt vmcnt(0)" ::: "memory");
        } else {
            XB_SPIN(xb_ld(&bar[XB_XGEN(x)]) == gen, bar);
            __builtin_amdgcn_fence(__ATOMIC_ACQUIRE, "agent");
            asm volatile("s_waitcnt vmcnt(0)" ::: "memory");
        }
    }
    __syncthreads();
}

__global__ void __launch_bounds__(NTHR, 2) fwd_megakernel(Params p) {
    extern __shared__ __attribute__((aligned(16))) unsigned char shm[];
    cg::grid_group grid = cg::this_grid();
    LAS unsigned char* lds = (LAS unsigned char*)shm;
    unsigned char* ws = p.ws;
    const int lo = p.lo, hi = p.hi;
    const int wv = __builtin_amdgcn_readfirstlane(threadIdx.x >> 6);
    if (threadIdx.x < 4) ((LAS unsigned*)(lds + 131072))[threadIdx.x] = 0u;
    __syncthreads();
    if (threadIdx.x == 0) (void)xb_add(&((unsigned*)(ws + OFF_BAR))[XB_XCNT(xb_xcc_id())], 1u);
    int pc = 0;
#define RUN (pc >= lo && pc < hi)
#define SEAM do { if (pc >= lo && pc + 1 < hi) xcd_barrier(wv, (unsigned*)(ws + OFF_BAR), (volatile LAS unsigned*)(lds + 131072)); ++pc; } while (0)

    if (RUN) phase0(p, (float*)shm);
    if (lo < 0) grid.sync();
    SEAM;
    if (RUN) phase_init_rows(p);
    SEAM;
#pragma unroll 1
    for (int l = 0; l < 4; ++l) {
        const int j = l >> 1; const bool even = (l & 1) == 0;
#pragma unroll 1
        for (int sub = 0; sub < 2; ++sub) {
            asm volatile("" : "+s"(ws));
            int G = gridDim.x, bid = blockIdx.x; asm volatile("" : "+s"(G), "+s"(bid));
            bf16_t* Hb = (bf16_t*)(ws + OFF_H); bf16_t* PROJ = (bf16_t*)(ws + OFF_PROJ); bf16_t* YAB = (bf16_t*)(ws + OFF_YAB); bf16_t* F1 = (bf16_t*)(ws + OFF_F1);
            bf16_t* XW = (bf16_t*)(ws + OFF_XW); const float* MOD = (const float*)(ws + OFF_MOD);
            if (sub == 0) {
                if (even) {
                    if (RUN) { pg8::SchedDense S{Hb, (const bf16_t*)(ws + OFF_WIN) + (size_t)j * 2097152, 1024, 1024, 64, 8, G, bid, 192, PROJ, 2048};
                        pg8::gemm_phase<3, true>(wv, lds, 1024, 1024, 1024, S, pg8::EpiBf<1>{}); }
                    SEAM;
                    if (RUN) {
                        { int hprev = -1; for (int u = bid; u < 384; u += G) { const int hd = u & 7; lru_unit(wv, p, j, u < 128 ? 32 + (u >> 3) : (u - 128) >> 3, hd, hd != hprev, shm); hprev = hd; } }
                        { const int half = G >> 1;
                          if (bid >= half) { int gprev = -1; for (int u = bid - half; u < 384; u += G - half) { const int k = u >> 3, g = k & 3; sgu_unit(wv, p, j, (k >> 2) * 8 + (u & 7), g, g != gprev, shm); gprev = g; } } }
                    }
                    SEAM;
                } else {
                    if (RUN) {
#pragma unroll 1
                        for (int part = 0; part < 2; ++part) {
                            const int half = G >> 1;
                            pg8::SchedD1 S{(const bf16_t*)(ws + OFF_CS256), (const bf16_t*)(ws + OFF_AS1024) + 1048576, Hb, PROJ, part == 0 ? G : G - half, part == 0 ? bid : bid - half, part};
                            const int kk = part == 0 ? 512 : 256;
                            pg8::gemm_phase<4, true>(wv, lds, kk, 1024, kk, S, pg8::EpiBf<0>{}, part == 0 ? 4 : (1 << 30), part == 0 ? (size_t)(512 * 1024 - 256) * 2 : (size_t)0);
                        } }
                    SEAM;
                    if (RUN) {
#pragma unroll 1
                        for (int part = 0; part < 2; ++part) {
                            pg8::SchedD2 S{(const bf16_t*)(ws + (part == 0 ? OFF_AS1024 : OFF_AS256)), PROJ, YAB, G, part == 0 ? bid : (bid + G - 64) % G, part};
                            const int kk = part == 0 ? 1024 : 512;
                            pg8::gemm_phase<4, true>(wv, lds, kk, part == 0 ? 2048 : 512, kk, S, pg8::EpiBf<0>{});
                        } }
                    SEAM;
                }
            } else {
                if (RUN) { pg8::SchedDense S{Hb, (const bf16_t*)(ws + OFF_W1) + (size_t)l * 4194304, 1024, 1024, 48, 16, G, bid, 256, F1, 4096};
                    pg8::gemm_phase<4, true>(wv, lds, 1024, 1024, 1024, S, pg8::EpiBf<2>{}); }
                SEAM;
            }
            if (RUN) {
                const bf16_t* A = sub == 0 ? YAB : F1;
                const bf16_t* Bt = sub == 0 ? (even ? (const bf16_t*)(ws + OFF_WOAB) : (const bf16_t*)(ws + OFF_WOC)) + (size_t)j * 1048576 : (const bf16_t*)(ws + OFF_W2) + (size_t)l * 4194304;
                const int K = sub == 0 ? 1024 : 4096;
                const bool final_ln = (l == 3 && sub == 1);
                const float* modn = final_ln ? nullptr : (sub == 0 ? MOD + l * 30720 + 3072 : MOD + (l + 1) * 30720);
                pg8::SchedDense S{A, Bt, K, K, 64, 4, G, bid, 192, YAB, 1024};
                pg8::EpiResidLn E{(const float*)(ws + OFF_PP) + PP_LNG + (l * 2 + sub) * 1024, (const float*)(ws + OFF_PP) + PP_LNB + (l * 2 + sub) * 1024, MOD + l * 30720 + (sub == 0 ? 2048 : 5120), modn, XW, p.out, Hb,
                                  (unsigned long long*)(ws + OFF_XCH), (unsigned*)(ws + OFF_CNT) + (l * 2 + sub) * 64 * 64};
                pg8::gemm_phase<3, false>(wv, lds, K, K, K, S, E);
            }
            SEAM;
        }
    }
#undef RUN
#undef SEAM
}

constexpr int N_PHASES = 2 + 4 * 5;

extern "C" void kernel_launch(void* const* d_in, const int* in_sizes, int n_in, void* d_out, int out_size, void* d_ws, size_t ws_size, hipStream_t stream) {
    static int grid_blocks = 0;
    if (!grid_blocks) {
        int dev = 0, cus = 0, per_cu = 0;
        hipGetDevice(&dev);
        hipDeviceGetAttribute(&cus, hipDeviceAttributeMultiprocessorCount, dev);
        if (hipFuncSetAttribute((const void*)fwd_megakernel, hipFuncAttributeMaxDynamicSharedMemorySize, LDS_BYTES) != hipSuccess) fprintf(stderr, "hipFuncSetAttribute failed\n");
        if (hipOccupancyMaxActiveBlocksPerMultiprocessor(&per_cu, (const void*)fwd_megakernel, NTHR, LDS_BYTES) != hipSuccess || per_cu < 1) { fprintf(stderr, "occupancy query: %d\n", per_cu); per_cu = 1; }
        (void)hipGetLastError();
        if (cus <= 0) cus = 256;
        grid_blocks = cus;
        if (ws_size < OFF_END) fprintf(stderr, "workspace too small: %zu < %zu\n", ws_size, (size_t)OFF_END);
    }
    (void)hipMemsetAsync((unsigned char*)d_ws + OFF_BAR, 0, 16384 + 131072 + 8192, stream);
    Params p{};
    for (int i = 0; i < 25; ++i) p.in[i] = (const float*)d_in[i];
    p.out = (float*)d_out; p.ws = (unsigned char*)d_ws;
#if PER_PHASE_LAUNCH
    for (int ph = 0; ph < N_PHASES; ++ph) {
        p.lo = ph; p.hi = ph + 1;
        void* args[] = {&p};
        hipError_t e = hipLaunchCooperativeKernel((const void*)fwd_megakernel, dim3(grid_blocks), dim3(NTHR), args, LDS_BYTES, stream);
        if (e != hipSuccess) { fprintf(stderr, "cooperative launch failed: %s (grid %d)\n", hipGetErrorString(e), grid_blocks); break; }
    }
#else
    p.lo = 0; p.hi = N_PHASES;
    void* args[] = {&p};
    hipError_t e = hipLaunchCooperativeKernel((const void*)fwd_megakernel, dim3(grid_blocks), dim3(NTHR), args, LDS_BYTES, stream);
    if (e != hipSuccess) fprintf(stderr, "cooperative launch failed: %s (grid %d)\n", hipGetErrorString(e), grid_blocks);
#endif
}
```
